# Optimizing an MI355X kernel written in HIP

```python
import math
import jax, jax.numpy as jnp
from jax import lax
import numpy as np

D_MODEL = 1024
BATCH = 32
SEQ = 256
DEPTH = 4
DEC_BATCH = 8
DEC_SEQ = 4096
PAST_LEN = 256

GRID_W = 64
N_MIXERS = 2
N_LRU_LAYERS = (DEPTH + 1) // 2
N_SG_LAYERS = DEPTH // 2
LRU_WIDTH = (4 * D_MODEL // 3) // 128 * 128
LRU_HEADS = LRU_WIDTH // 128
LRU_BLOCK = LRU_WIDTH // LRU_HEADS
LRU_C = 8.0
CONV_W = 4
CHUNK = 128
SG_WIDTH = 2 * D_MODEL
SG_GROUPS = 8
SG_GROUP_DIM = SG_WIDTH // SG_GROUPS
N_EXPERTS = 16
EC_FACTOR = 2
EXPERT_FF = D_MODEL
RMS_EPS = 1e-6
POS_BASE = 10000.0

kernel_name = 'hybrid_rglru_sgmlp_ec_diffusion_step'


def _rmsnorm(x, g):
    xf = x.astype(jnp.float32)
    y = xf * lax.rsqrt(jnp.mean(xf * xf, axis=-1, keepdims=True) + RMS_EPS)
    return (y * g.astype(jnp.float32)).astype(x.dtype)


def _grid_pos_embed(n_tokens, dtype):
    rows = n_tokens // GRID_W
    row = jnp.repeat(jnp.arange(rows, dtype=jnp.float32), GRID_W)
    col = jnp.tile(jnp.arange(GRID_W, dtype=jnp.float32), rows)
    q = D_MODEL // 4
    freq = jnp.exp(-math.log(POS_BASE) * jnp.arange(q, dtype=jnp.float32) / q)
    ang_r = row[:, None] * freq
    ang_c = col[:, None] * freq
    emb = jnp.concatenate([jnp.sin(ang_r), jnp.cos(ang_r), jnp.sin(ang_c), jnp.cos(ang_c)], axis=-1)
    return emb.astype(dtype)


def _centred_depthwise_conv(x, w, b):
    t = x.shape[1]
    left = CONV_W // 2
    xp = jnp.pad(x, ((0, 0), (left, CONV_W - 1 - left), (0, 0)))
    return sum(xp[:, k:k + t] * w[k] for k in range(CONV_W)) + b


def _linear_scan(a, u, h0, reverse):
    if reverse:
        a = jnp.flip(a, axis=1)
        u = jnp.flip(u, axis=1)

    def combine(lhs, rhs):
        a_l, u_l = lhs
        a_r, u_r = rhs
        return a_l * a_r, a_r * u_l + u_r

    a_cum, u_cum = lax.associative_scan(combine, (a, u), axis=1)
    h = u_cum + a_cum * h0[:, None, :]
    final = h[:, -1]
    if reverse:
        h = jnp.flip(h, axis=1)
    return h, final


def _rglru_mixer(h, h0, w_in, conv_w, conv_b, w_a, b_a, w_x, b_x, lam, w_out):
    bsz, t, _ = h.shape
    proj = h @ w_in
    gate = jax.nn.gelu(proj[..., :LRU_WIDTH])
    xb = _centred_depthwise_conv(proj[..., LRU_WIDTH:], conv_w, conv_b)
    xh = xb.reshape(bsz, t, LRU_HEADS, LRU_BLOCK)
    hs, finals = [], []
    for d in range(2):
        r = jax.nn.sigmoid(jnp.einsum('bthi,hij->bthj', xh, w_a[d]).reshape(bsz, t, LRU_WIDTH) + b_a[d])
        i = jax.nn.sigmoid(jnp.einsum('bthi,hij->bthj', xh, w_x[d]).reshape(bsz, t, LRU_WIDTH) + b_x[d])
        log_a = -LRU_C * r.astype(jnp.float32) * jax.nn.softplus(-lam[d].astype(jnp.float32))
        a = jnp.exp(log_a)
        u = jnp.sqrt(-jnp.expm1(2.0 * log_a)) * (i * xb).astype(jnp.float32)
        h_d, fin = _linear_scan(a, u, h0[:, d].astype(jnp.float32), reverse=(d == 1))
        hs.append(h_d)
        finals.append(fin)
    y = ((hs[0] + hs[1]).astype(h.dtype) * gate) @ w_out
    return y, jnp.stack(finals, axis=1)


def _sgu_mixer(h, w_in, norm_g, w_s, b_s, w_out):
    bsz, t, _ = h.shape
    proj = jax.nn.gelu(h @ w_in)
    u = proj[..., :SG_WIDTH]
    v = _rmsnorm(proj[..., SG_WIDTH:], norm_g).reshape(bsz, t // CHUNK, CHUNK, SG_GROUPS, SG_GROUP_DIM)
    sv = jnp.einsum('gpq,bnqgc->bnpgc', w_s, v) + b_s.T[None, None, :, :, None]
    return (u * sv.reshape(bsz, t, SG_WIDTH)) @ w_out


def _ec_moe(x, router, w_gate, w_up, w_down):
    bsz, t, d = x.shape
    xf = x.reshape(bsz * t, d)
    cap = EC_FACTOR * (bsz * t) // N_EXPERTS
    aff = jax.nn.softmax(xf.astype(jnp.float32) @ router.astype(jnp.float32), axis=-1)
    g, idx = lax.top_k(aff.T, cap)
    xs = xf[idx]
    hh = jax.nn.silu(jnp.einsum('ecd,edf->ecf', xs, w_gate)) * jnp.einsum('ecd,edf->ecf', xs, w_up)
    out = jnp.einsum('ecf,efd->ecd', hh, w_down) * g[..., None].astype(x.dtype)
    y = jnp.zeros_like(xf).at[idx.reshape(-1)].add(out.reshape(-1, d))
    return y.reshape(bsz, t, d)


def _trunk(x, cond, h0, p):
    finals = []
    sc = jax.nn.silu(cond)
    for l in range(DEPTH):
        mod = (sc @ p['w_mod'][l] + p['b_mod'][l])[:, None, :]
        sh1, s1, g1, sh2, s2, g2 = jnp.split(mod, 6, axis=-1)
        hn = _rmsnorm(x, p['norm1_g'][l]) * (1 + s1) + sh1
        j = l // N_MIXERS
        if l % N_MIXERS == 0:
            y, fin = _rglru_mixer(hn, h0[:, j], p['lru_w_in'][j], p['lru_conv_w'][j], p['lru_conv_b'][j],
                                  p['lru_w_a'][j], p['lru_b_a'][j], p['lru_w_x'][j], p['lru_b_x'][j],
                                  p['lru_lam'][j], p['lru_w_out'][j])
            finals.append(fin)
        else:
            y = _sgu_mixer(hn, p['sg_w_in'][j], p['sg_norm_g'][j], p['sg_w_s'][j], p['sg_b_s'][j],
                           p['sg_w_out'][j])
        x = x + g1 * y
        hn = _rmsnorm(x, p['norm2_g'][l]) * (1 + s2) + sh2
        x = x + g2 * _ec_moe(hn, p['moe_router'][l], p['moe_w_gate'][l], p['moe_w_up'][l], p['moe_w_down'][l])
    return _rmsnorm(x, p['final_norm_g']), jnp.stack(finals, axis=1)


def setup_inputs(seed: int = 0) -> dict:
    key = jax.random.key(seed)
    ks = jax.random.split(key, 28)
    nrm = jax.random.normal
    f = jnp.float32
    d = D_MODEL
    a0 = jax.random.uniform(ks[16], (N_LRU_LAYERS, 2, LRU_WIDTH), f, minval=0.9, maxval=0.999)
    s = a0 ** (1.0 / LRU_C)
    lam = jnp.log(s) - jnp.log1p(-s)
    return {
        'x_prompt': nrm(ks[0], (BATCH, SEQ, d), f),
        'x_sample': nrm(ks[1], (DEC_BATCH, DEC_SEQ, d), f),
        'state_lru': nrm(ks[2], (DEC_BATCH, N_LRU_LAYERS, 2, LRU_WIDTH), f),
        'c': nrm(ks[3], (DEC_BATCH, d), f),
        'c_ctx': nrm(ks[4], (d,), f),
        'norm1_g': 1.0 + 0.01 * nrm(ks[5], (DEPTH, d), f),
        'norm2_g': 1.0 + 0.01 * nrm(ks[6], (DEPTH, d), f),
        'w_mod': nrm(ks[7], (DEPTH, d, 6 * d), f) * (0.25 * d ** -0.5),
        'b_mod': 0.01 * nrm(ks[8], (DEPTH, 6 * d), f),
        'lru_w_in': nrm(ks[9], (N_LRU_LAYERS, d, 2 * LRU_WIDTH), f) * d ** -0.5,
        'lru_conv_w': nrm(ks[10], (N_LRU_LAYERS, CONV_W, LRU_WIDTH), f) * CONV_W ** -0.5,
        'lru_conv_b': 0.01 * nrm(ks[11], (N_LRU_LAYERS, LRU_WIDTH), f),
        'lru_w_a': nrm(ks[12], (N_LRU_LAYERS, 2, LRU_HEADS, LRU_BLOCK, LRU_BLOCK), f) * LRU_BLOCK ** -0.5,
        'lru_b_a': 0.01 * nrm(ks[13], (N_LRU_LAYERS, 2, LRU_WIDTH), f),
        'lru_w_x': nrm(ks[14], (N_LRU_LAYERS, 2, LRU_HEADS, LRU_BLOCK, LRU_BLOCK), f) * LRU_BLOCK ** -0.5,
        'lru_b_x': 0.01 * nrm(ks[15], (N_LRU_LAYERS, 2, LRU_WIDTH), f),
        'lru_lam': lam,
        'lru_w_out': nrm(ks[17], (N_LRU_LAYERS, LRU_WIDTH, d), f) * LRU_WIDTH ** -0.5,
        'sg_w_in': nrm(ks[18], (N_SG_LAYERS, d, 2 * SG_WIDTH), f) * d ** -0.5,
        'sg_norm_g': 1.0 + 0.01 * nrm(ks[19], (N_SG_LAYERS, SG_WIDTH), f),
        'sg_w_s': nrm(ks[20], (N_SG_LAYERS, SG_GROUPS, CHUNK, CHUNK), f) * CHUNK ** -0.5,
        'sg_b_s': 1.0 + 0.1 * nrm(ks[21], (N_SG_LAYERS, SG_GROUPS, CHUNK), f),
        'sg_w_out': nrm(ks[22], (N_SG_LAYERS, SG_WIDTH, d), f) * SG_WIDTH ** -0.5,
        'moe_router': nrm(ks[23], (DEPTH, d, N_EXPERTS), f) * d ** -0.5,
        'moe_w_gate': nrm(ks[24], (DEPTH, N_EXPERTS, d, EXPERT_FF), f) * d ** -0.5,
        'moe_w_up': nrm(ks[25], (DEPTH, N_EXPERTS, d, EXPERT_FF), f) * d ** -0.5,
        'moe_w_down': nrm(ks[26], (DEPTH, N_EXPERTS, EXPERT_FF, d), f) * EXPERT_FF ** -0.5,
        'final_norm_g': 1.0 + 0.01 * nrm(ks[27], (d,), f),
    }


def reference(x_prompt, x_sample, state_lru, c, c_ctx, norm1_g, norm2_g, w_mod, b_mod,
              lru_w_in, lru_conv_w, lru_conv_b, lru_w_a, lru_b_a, lru_w_x, lru_b_x, lru_lam, lru_w_out,
              sg_w_in, sg_norm_g, sg_w_s, sg_b_s, sg_w_out,
              moe_router, moe_w_gate, moe_w_up, moe_w_down, final_norm_g):
    p = {
        'norm1_g': norm1_g, 'norm2_g': norm2_g, 'w_mod': w_mod, 'b_mod': b_mod,
        'lru_w_in': lru_w_in, 'lru_conv_w': lru_conv_w, 'lru_conv_b': lru_conv_b,
        'lru_w_a': lru_w_a, 'lru_b_a': lru_b_a, 'lru_w_x': lru_w_x, 'lru_b_x': lru_b_x,
        'lru_lam': lru_lam, 'lru_w_out': lru_w_out,
        'sg_w_in': sg_w_in, 'sg_norm_g': sg_norm_g, 'sg_w_s': sg_w_s, 'sg_b_s': sg_b_s, 'sg_w_out': sg_w_out,
        'moe_router': moe_router, 'moe_w_gate': moe_w_gate, 'moe_w_up': moe_w_up, 'moe_w_down': moe_w_down,
        'final_norm_g': final_norm_g,
    }
    h0_ctx = jnp.zeros((x_prompt.shape[0], N_LRU_LAYERS, 2, LRU_WIDTH), jnp.float32)
    y_prompt, new_state_lru = _trunk(x_prompt, c_ctx[None, :], h0_ctx, p)
    xs = x_sample + _grid_pos_embed(x_sample.shape[1], x_sample.dtype)[None]
    y_sample, _ = _trunk(xs, c, state_lru, p)
    return (y_prompt, y_sample, new_state_lru)
```

```cpp
#include <hip/hip_runtime.h>
#include <stdint.h>

#ifndef PROBE_KIND
#define PROBE_KIND 0
#endif
#ifndef MK_PER_PHASE
#define MK_PER_PHASE 0
#endif

typedef unsigned short bf16_t;
constexpr int DM = 1024, NCTX = 8192, NSMP = 32768, NTOK = 40960;
constexpr int LW = 1280, SGW = 2048, NE = 16;
constexpr int CAP_CTX = 1024, CAP_SMP = 4096, SLOTS_E = 5120, NSLOT = NE * SLOTS_E;
constexpr int NCK = NTOK / 256;
constexpr float RMS_EPS = 1e-6f;
#define LAS __attribute__((address_space(3)))

__device__ __forceinline__ float bf2f(bf16_t b) { return __uint_as_float(((unsigned)b) << 16); }
__device__ __forceinline__ bf16_t f2bf(float f) { unsigned r; asm("v_cvt_pk_bf16_f32 %0, %1, %1" : "=v"(r) : "v"(f)); return (bf16_t)r; }
__device__ __forceinline__ int tok_cond(int r) { return r < NCTX ? 0 : 1 + ((r - NCTX) >> 12); }
__device__ __forceinline__ float shx(float v, int o, int lane) { return __int_as_float(__builtin_amdgcn_ds_bpermute((lane ^ o) << 2, __float_as_int(v))); }
__device__ __forceinline__ unsigned shxu(unsigned v, int o, int lane) { return (unsigned)__builtin_amdgcn_ds_bpermute((lane ^ o) << 2, (int)v); }
__device__ __forceinline__ unsigned shupu(unsigned v, int o, int lane) { return (unsigned)__builtin_amdgcn_ds_bpermute(((lane - o) & 63) << 2, (int)v); }
__device__ __forceinline__ float wave_sum(float v, int lane) {
#pragma unroll
    for (int o = 32; o >= 1; o >>= 1) v += shx(v, o, lane);
    return v;
}


struct Ids { int tid, lane, wid, bid, G, gw, ngw; };
__device__ __forceinline__ Ids fresh_ids(int wv) {
    Ids d; unsigned ones = ~0u; asm volatile("" : "+s"(ones)); int ln = (int)__builtin_amdgcn_mbcnt_hi(ones, __builtin_amdgcn_mbcnt_lo(ones, 0u)); asm volatile("" : "+v"(ln)); int w = wv; asm volatile("" : "+s"(w)); int b = blockIdx.x; asm volatile("" : "+s"(b));
    d.tid = w * 64 + ln; d.lane = ln; d.wid = w; d.bid = b; d.G = gridDim.x; d.gw = b * 8 + w; d.ngw = d.G * 8; return d;
}

struct P {
    const float *x_prompt, *x_sample, *state_lru, *c, *c_ctx, *norm1_g, *norm2_g, *w_mod, *b_mod;
    const float *lru_w_in, *lru_conv_w, *lru_conv_b, *lru_w_a, *lru_b_a, *lru_w_x, *lru_b_x, *lru_lam, *lru_w_out;
    const float *sg_w_in, *sg_norm_g, *sg_w_s, *sg_b_s, *sg_w_out;
    const float *moe_router, *moe_w_gate, *moe_w_up, *moe_w_down, *final_norm_g;
    bf16_t* x;
    float* xout;
    float* new_state;
    unsigned* bar;
    float* mod;
    bf16_t *hn, *y;
    bf16_t *gate, *xpre, *S, *zl;
    unsigned char *Af, *Ab;
    float* agg;
    float* k2tab;
    bf16_t *proj;
    bf16_t *zsg;
    float* vss;
    float* affT;
    float* affT2;
    int* idx;
    float* gsel;
    int* inv;
    unsigned char* hh8;
    unsigned char* hn8;
    unsigned char* outm;
    bf16_t *wt_lru_in, *wt_lru_out, *wt_sg_out, *wt_a, *wt_x;
    signed char *wq_lru_in, *wq_sg_in;
    float *wsc_lru_in, *wsc_sg_in;
    float* wpm_sg_in;
    signed char* hn8i;
    float* hsc;
    unsigned char* wt8;
};


#define XB_TMO      128
#define XB_XCNT(j)  (256  + 64 * (j))
#define XB_XSUB(j)  (1280 + 64 * (j))
#define XB_XGEN(j)  (2304 + 64 * (j))
#define XB_TOP      3328
#define XB_TOPGEN   3392
#define XCD_BAR_WORDS 3456
#define XB_SPIN_CAP (1u << 18)
__device__ __forceinline__ unsigned xb_ld(unsigned* p)              { return __hip_atomic_load(p, __ATOMIC_RELAXED, __HIP_MEMORY_SCOPE_AGENT); }
__device__ __forceinline__ unsigned xb_add(unsigned* p, unsigned v) { return __hip_atomic_fetch_add(p, v, __ATOMIC_RELAXED, __HIP_MEMORY_SCOPE_AGENT); }
__device__ __forceinline__ unsigned xb_xcc_id() { return (unsigned)__builtin_amdgcn_s_getreg((3 << 11) | 20) & 0xFu; }
#define XB_SPIN(cond, bar) do { unsigned _sp = 0; while (cond) { __builtin_amdgcn_s_sleep(1); \
    if ((++_sp & 255u) == 0u) { if (xb_ld(&(bar)[XB_TMO])) break; if (_sp > XB_SPIN_CAP) { atomicAdd(&(bar)[XB_TMO], 1u); break; } } } } while (0)
struct XcdBarrier { unsigned* bar; unsigned x; volatile LAS unsigned* st; };
__device__ __forceinline__ XcdBarrier xcd_barrier_post(unsigned* bar, volatile LAS unsigned* st) {
    XcdBarrier b; b.bar = bar; b.x = xb_xcc_id(); b.st = st;
    if (threadIdx.x == 0) (void)xb_add(&bar[XB_XCNT(b.x)], 1u);
    return b;
}
__device__ __forceinline__ void xcd_barrier_complete(unsigned* bar, unsigned x, unsigned& nloc, unsigned& nx) {
    const unsigned G = gridDim.x * gridDim.y * gridDim.z;
    unsigned sum, cnt, mine, sp = 0u;
    for (;;) {
        sum = 0u; cnt = 0u; mine = 0u;
#pragma unroll
        for (unsigned j = 0; j < 16; ++j) { const unsigned c = xb_ld(&bar[XB_XCNT(j)]); sum += c; cnt += (c > 0u) ? 1u : 0u; mine = (j == x) ? c : mine; }
        if (sum == G) break;
        __builtin_amdgcn_s_sleep(1);
        if ((++sp & 255u) == 0u) { if (xb_ld(&bar[XB_TMO])) break; if (sp > XB_SPIN_CAP) { atomicAdd(&bar[XB_TMO], 1u); break; } }
    }
    nloc = mine > 0u ? mine : 1u; nx = cnt > 0u ? cnt : 1u;
}
__device__ __forceinline__ void xcd_barrier(const XcdBarrier& b) {
    asm volatile("s_waitcnt vmcnt(0)" ::: "memory");
    __syncthreads();
    if (threadIdx.x == 0) {
        unsigned* bar = b.bar;
        __builtin_amdgcn_s_waitcnt(0);
        unsigned nloc = b.st[0], nx = b.st[1];
        if (nloc == 0u) { xcd_barrier_complete(bar, b.x, nloc, nx); b.st[0] = nloc; b.st[1] = nx; }
        const unsigned old = xb_add(&bar[XB_XSUB(b.x)], 1u);
        const unsigned gen = old / nloc;
        if (old + 1u == (gen + 1u) * nloc) {
            __builtin_amdgcn_fence(__ATOMIC_RELEASE, "agent");
            asm volatile("s_waitcnt vmcnt(0)" ::: "memory");
            const unsigned og = xb_add(&bar[XB_TOP], 1u);
            const unsigned tg = og / nx;
            if (og + 1u == (tg + 1u) * nx) xb_add(&bar[XB_TOPGEN], 1u);
            else XB_SPIN(xb_ld(&bar[XB_TOPGEN]) == tg, bar);
            __builtin_amdgcn_fence(__ATOMIC_ACQUIRE, "agent");
            xb_add(&bar[XB_XGEN(b.x)], 1u);
            asm volatile("s_waitcnt vmcnt(0)" ::: "memory");
        } else {
            XB_SPIN(xb_ld(&bar[XB_XGEN(b.x)]) == gen, bar);
            __builtin_amdgcn_fence(__ATOMIC_ACQUIRE, "agent");
            asm volatile("s_waitcnt vmcnt(0)" ::: "memory");
        }
    }
    __syncthreads();
}

__device__ __forceinline__ void transpose32(unsigned (&A)[32]) {
#pragma unroll
    for (int s = 0; s < 5; ++s) {
        const int j = 16 >> s;
        const unsigned m = (s == 0) ? 0x0000ffffu : (s == 1) ? 0x00ff00ffu : (s == 2) ? 0x0f0f0f0fu : (s == 3) ? 0x33333333u : 0x55555555u;
#pragma unroll
        for (int blk = 0; blk < 32; blk += 2 * j)
#pragma unroll
            for (int i = 0; i < j; ++i) { const int k = blk + i; const unsigned t = ((A[k] >> j) ^ A[k + j]) & m; A[k] ^= t << j; A[k + j] ^= t; }
    }
}
__device__ __forceinline__ unsigned wave_total_u32(unsigned v) {
    v += (unsigned)__builtin_amdgcn_update_dpp(0, (int)v, 0x111, 0xf, 0xf, false);
    v += (unsigned)__builtin_amdgcn_update_dpp(0, (int)v, 0x112, 0xf, 0xf, false);
    v += (unsigned)__builtin_amdgcn_update_dpp(0, (int)v, 0x114, 0xf, 0xf, false);
    v += (unsigned)__builtin_amdgcn_update_dpp(0, (int)v, 0x118, 0xf, 0xf, false);
    return (unsigned)(__builtin_amdgcn_readlane((int)v, 15) + __builtin_amdgcn_readlane((int)v, 31)) + (unsigned)(__builtin_amdgcn_readlane((int)v, 47) + __builtin_amdgcn_readlane((int)v, 63));
}
template <int CNT> __device__ __forceinline__ void select_body(const P& p, const float* affsrc, int e, int base_tok, int cap, int slot_base, LAS unsigned (*red)[8], int wv, int early = 0) {
    const Ids I = fresh_ids(wv); const int tid = I.tid, lane = I.lane, wid = I.wid;
    const float* col = affsrc + (size_t)e * NTOK + base_tok + tid * CNT;
    unsigned key[CNT];
#pragma unroll
    for (int k = 0; k < CNT; k += 4) { const float4 v = *(const float4*)(col + k); key[k] = __float_as_uint(v.x); key[k + 1] = __float_as_uint(v.y); key[k + 2] = __float_as_uint(v.z); key[k + 3] = __float_as_uint(v.w); }
    constexpr int NBLK = (CNT + 31) / 32;
    unsigned pl[NBLK][32], alive[NBLK];
#pragma unroll
    for (int b = 0; b < NBLK; ++b) {
#pragma unroll
        for (int r = 0; r < 32; ++r) pl[b][r] = (b * 32 + r < CNT) ? key[(b * 32 + r < CNT) ? b * 32 + r : 0] : 0u;
        transpose32(pl[b]);
        alive[b] = (CNT - 32 * b >= 32) ? 0xffffffffu : ((1u << ((CNT - 32 * b) & 31)) - 1u);
    }
    unsigned T = 0u, above = 0u, cg = 0u; int pp = 0;
#pragma unroll
    for (int bit = 30; bit >= 0; --bit) {
        unsigned m[NBLK], c = 0u;
#pragma unroll
        for (int b = 0; b < NBLK; ++b) { m[b] = alive[b] & pl[b][bit]; c += (unsigned)__builtin_popcount(m[b]); }
        const unsigned wsum = wave_total_u32(c);
        if (lane == 0) red[pp][wid] = wsum;
        __syncthreads();
        unsigned part = 0;
#pragma unroll
        for (int w = 0; w < 8; ++w) part += red[pp][w];
        const bool take = above + part >= (unsigned)cap;
        if (take) T |= 1u << bit; else { above += part; cg += c; }
#pragma unroll
        for (int b = 0; b < NBLK; ++b) alive[b] = take ? m[b] : (alive[b] ^ m[b]);
        pp ^= 1;
    }
    if (PROBE_KIND == 17 && early) { if (tid == 0) p.affT2[(size_t)e * NTOK + base_tok] = __uint_as_float(T); return; }
    unsigned ceq = 0u;
#pragma unroll
    for (int b = 0; b < NBLK; ++b) ceq += (unsigned)__builtin_popcount(alive[b]);
    unsigned pg = cg, pe = ceq;
#pragma unroll
    for (int o = 1; o < 64; o <<= 1) { const unsigned a = shupu(pg, o, lane), b = shupu(pe, o, lane); if (lane >= o) { pg += a; pe += b; } }
    __syncthreads();
    if (lane == 63) { red[0][wid] = pg; red[1][wid] = pe; }
    __syncthreads();
    unsigned offg = 0, offe = 0, totg = 0;
#pragma unroll
    for (int w = 0; w < 8; ++w) { if (w < wid) { offg += red[0][w]; offe += red[1][w]; } totg += red[0][w]; }
    const unsigned need = (unsigned)cap - totg;
    unsigned eg = offg + pg - cg;
    unsigned ee = offe + pe - ceq;
    constexpr int N = CNT * 512, ISTR = CNT + 2;
    LAS short* invS = (LAS short*)((LAS unsigned char*)red + 256);
    LAS int* idxS = (LAS int*)((LAS unsigned char*)invS + 512 * ISTR * 2);
    LAS unsigned* gS = (LAS unsigned*)(idxS + CNT * 64);
#pragma unroll
    for (int k = 0; k < CNT; ++k) {
        const bool gt = key[k] > T, eq = key[k] == T;
        const bool sel = gt || (eq && ee < need);
        int pos = -1;
        if (sel) { pos = (int)(eg + (ee < need ? ee : need)); idxS[pos] = base_tok + tid * CNT + k; gS[pos] = key[k]; }
        eg += gt ? 1u : 0u; ee += eq ? 1u : 0u;
        invS[tid * ISTR + k] = (short)pos;
    }
    __syncthreads();
    const int sbase = e * SLOTS_E + slot_base;
    int* invg = p.inv + (size_t)e * NTOK + base_tok;
    for (int i = tid; i < N; i += 512) { const int t = i / CNT, k = i - t * CNT; const int v = invS[t * ISTR + k]; invg[i] = v < 0 ? -1 : sbase + v; }
    for (int i = tid; i < CNT * 64; i += 512) { p.idx[sbase + i] = idxS[i]; p.gsel[sbase + i] = __uint_as_float(gS[i]); }
}

typedef short bf16x8 __attribute__((ext_vector_type(8)));
typedef float f32x4 __attribute__((ext_vector_type(4)));
typedef float f32x2 __attribute__((ext_vector_type(2)));
typedef unsigned u32x4 __attribute__((ext_vector_type(4)));
typedef unsigned u32x2 __attribute__((ext_vector_type(2)));
__device__ __forceinline__ float h2f(unsigned h) { return (float)__builtin_bit_cast(_Float16, (unsigned short)h); }
__device__ __forceinline__ unsigned f2h(float f) { return (unsigned)__builtin_bit_cast(unsigned short, (_Float16)f); }
__device__ __forceinline__ float4 xs_unpack(u32x2 w) { return make_float4(h2f(w[0] & 0xffffu), h2f(w[0] >> 16), h2f(w[1] & 0xffffu), h2f(w[1] >> 16)); }
__device__ __forceinline__ u32x2 xs_pack(float4 v) { u32x2 o; o[0] = f2h(v.x) | (f2h(v.y) << 16); o[1] = f2h(v.z) | (f2h(v.w) << 16); return o; }

namespace pg8 {
constexpr int BM = 256, BK = 64, HALF = 128, HTB = HALF * BK * 2, STAGE_BYTES = 8 * HTB, NXCD = 8, WGM = 8;
__host__ __device__ __forceinline__ int lds_byte(int r, int c) { const int st = (r >> 4) * 2 + (c >> 5), rr = r & 15, cc = c & 31, ob = rr * 64 + cc * 2; return st * 1024 + (ob ^ (((ob >> 9) & 1) << 5)); }
__host__ __device__ __forceinline__ void stage_rc(int b, int& R, int& C) { const int st = b / 1024, sb = b % 1024, swz = sb ^ (((sb >> 9) & 1) << 5); R = (st >> 1) * 16 + swz / 64; C = (st & 1) * 32 + (swz % 64) / 2; }
__host__ __device__ __forceinline__ int perm32(int rho) { const int n = rho >> 4, i = rho & 15; return 8 * (i >> 2) + 4 * n + (i & 3); }
struct Unit { int pm, pn; };
struct StaticOrder {
    int nM, nN, nwg, G, c;
    __host__ __device__ void init(int M, int N, int G_, int c_) { nM = M / BM; nN = N / BM; nwg = nM * nN; G = G_; c = c_; }
    __host__ __device__ bool next(int i, Unit& u) const {
        const long L = (long)i * G + c; if (L >= nwg) return false;
        int wgid = (int)L; { const int q = nwg / NXCD, r = nwg % NXCD, xcd = wgid % NXCD, off = wgid / NXCD; wgid = (xcd < r ? xcd * (q + 1) : r * (q + 1) + (xcd - r) * q) + off; }
        const int nig = WGM * nN, gid = wgid / nig, fm = gid * WGM, gsz = (nM % WGM == 0) ? WGM : ((nM - fm) < WGM ? (nM - fm) : WGM);
        u.pm = fm + ((wgid % nig) % gsz); u.pn = (wgid % nig) / gsz; return true;
    }
};
__device__ __forceinline__ unsigned cvt_pk_bf16(float lo, float hi) { unsigned r; asm volatile("v_cvt_pk_bf16_f32 %0, %1, %2" : "=v"(r) : "v"(lo), "v"(hi)); return r; }
__device__ __forceinline__ float fast_sigmoid(float x) { return __builtin_amdgcn_rcpf(1.0f + __builtin_amdgcn_exp2f(-1.44269504089f * x)); }
__device__ __forceinline__ f32x4 gelu_fast4(f32x4 x) {
    const float c0 = -1.44269504089f * 1.5957691216057308f, c1 = c0 * 0.044715f;
    f32x2 a; a[0] = x[0]; a[1] = x[1]; f32x2 b; b[0] = x[2]; b[1] = x[3];
    f32x2 ta = __builtin_elementwise_fma(a * a, (f32x2){c1, c1}, (f32x2){c0, c0}) * a, tb = __builtin_elementwise_fma(b * b, (f32x2){c1, c1}, (f32x2){c0, c0}) * b;
    f32x2 da, db; da[0] = __builtin_amdgcn_exp2f(ta[0]); da[1] = __builtin_amdgcn_exp2f(ta[1]); db[0] = __builtin_amdgcn_exp2f(tb[0]); db[1] = __builtin_amdgcn_exp2f(tb[1]);
    da = da + 1.0f; db = db + 1.0f;
    f32x2 ra, rb; ra[0] = __builtin_amdgcn_rcpf(da[0]); ra[1] = __builtin_amdgcn_rcpf(da[1]); rb[0] = __builtin_amdgcn_rcpf(db[0]); rb[1] = __builtin_amdgcn_rcpf(db[1]);
    ra = ra * a; rb = rb * b;
    f32x4 o; o[0] = ra[0]; o[1] = ra[1]; o[2] = rb[0]; o[3] = rb[1]; return o;
}
__device__ __forceinline__ f32x4 silu_mul4(f32x4 g, f32x4 u) {
    f32x2 a; a[0] = g[0]; a[1] = g[1]; f32x2 b; b[0] = g[2]; b[1] = g[3]; f32x2 ua; ua[0] = u[0]; ua[1] = u[1]; f32x2 ub; ub[0] = u[2]; ub[1] = u[3];
    const f32x2 za = a * -1.44269504089f, zb = b * -1.44269504089f;
    f32x2 da, db; da[0] = __builtin_amdgcn_exp2f(za[0]); da[1] = __builtin_amdgcn_exp2f(za[1]); db[0] = __builtin_amdgcn_exp2f(zb[0]); db[1] = __builtin_amdgcn_exp2f(zb[1]);
    da = da + 1.0f; db = db + 1.0f;
    f32x2 ra, rb; ra[0] = __builtin_amdgcn_rcpf(da[0]); ra[1] = __builtin_amdgcn_rcpf(da[1]); rb[0] = __builtin_amdgcn_rcpf(db[0]); rb[1] = __builtin_amdgcn_rcpf(db[1]);
    ra = (a * ra) * ua; rb = (b * rb) * ub;
    f32x4 o; o[0] = ra[0]; o[1] = ra[1]; o[2] = rb[0]; o[3] = rb[1]; return o;
}
__device__ __forceinline__ float gelu_fast(float x) { const float u2 = 1.5957691216057308f * (x + 0.044715f * x * x * x); return x * fast_sigmoid(u2); }

enum Kind { K_LRU_IN = 0, K_SG_IN = 1, K_OUT = 2, K_MOE1 = 3, K_MOE2 = 4 };
typedef int i32x8 __attribute__((ext_vector_type(8)));
typedef int i32x4 __attribute__((ext_vector_type(4)));
__device__ __forceinline__ unsigned pack4_fp8(float a, float b, float c, float d) { int v = 0; v = __builtin_amdgcn_cvt_pk_fp8_f32(a, b, v, false); v = __builtin_amdgcn_cvt_pk_fp8_f32(c, d, v, true); return (unsigned)v; }
template <int KIND, int KK> struct Prob {
    static constexpr int K = KK;
    static constexpr bool FP8 = (KIND == K_MOE1 || KIND == K_MOE2);
    static constexpr bool I8 = (KIND == K_SG_IN);
    static constexpr int ROWB = (FP8 || I8) ? KK : 2 * KK;
    static constexpr bool GATHER = (KIND == K_MOE1);
    const void* A; const void* B0; const void* B1;
    void* O0; bf16_t* O1; float* vss; const int* idx; const float* gsel; const float* gvec;
    StaticOrder S;
    LAS unsigned* tab;
    __device__ __forceinline__ bool next(int i, Unit& u) const { return S.next(i, u); }
    __device__ __forceinline__ void prep(int tid) const {
        if constexpr (KIND == K_MOE1 || KIND == K_MOE2 || I8) {
            const int r = tid & 255, par = tid >> 8;
            for (int i0 = 0; ; i0 += 16) {
                unsigned v[8]; bool ok[8];
#pragma unroll
                for (int j = 0; j < 8; ++j) { Unit u; ok[j] = S.next(i0 + 2 * j + par, u); const int src = ok[j] ? u.pm * 256 + r : 0;
                    if constexpr (KIND == K_MOE1) v[j] = (unsigned)idx[src] * (unsigned)ROWB; else v[j] = __float_as_uint(gsel[src]); }
#pragma unroll
                for (int j = 0; j < 8; ++j) if (ok[j]) tab[(i0 + 2 * j + par) * 256 + r] = v[j];
                Unit u2; if (!S.next(i0 + 16, u2)) break;
            }
            __syncthreads();
        }
    }
    __device__ __forceinline__ void a_off(const Unit& u, int ui, const int (&R)[2], const int (&C)[2], unsigned (&off)[2][2]) const {
#pragma unroll
        for (int h = 0; h < 2; ++h)
#pragma unroll
            for (int i = 0; i < 2; ++i) {
                if constexpr (KIND == K_MOE1) off[h][i] = tab[ui * 256 + h * 128 + R[i]] + (unsigned)(C[i] * 2);
                else off[h][i] = (unsigned)(u.pm * 256 + h * 128 + R[i]) * (unsigned)ROWB + (unsigned)(C[i] * 2);
            }
    }
    __device__ __forceinline__ const char* b_half(const Unit& u, int h) const {
        if constexpr (KIND == K_MOE1) { const int e = u.pm / 20; return (const char*)(h ? B1 : B0) + ((size_t)e * 1024 + (size_t)u.pn * 128) * ROWB; }
        else if constexpr (KIND == K_MOE2) { const int e = u.pm / 20; return (const char*)B0 + ((size_t)e * 1024 + (size_t)u.pn * 256 + h * 128) * ROWB; }
        else return (const char*)B0 + ((size_t)u.pn * 256 + h * 128) * ROWB;
    }
    __device__ __forceinline__ void epi(const f32x4 (&acc)[2][2][4][2], const Unit& u, int ui, int wr, int wc, int fr, int fq) const {
        const int rloc0 = wr * 64 + fr, lane = fq * 16 + fr;
        const int cl = wc * 32 + 8 * fq;
        if constexpr (KIND == K_OUT) {
            const int ci = tok_cond(u.pm * 256);
            const float* g1p = gvec + (size_t)ci * 6144 + 2048 + u.pn * 256 + cl;
            f32x4 g[2][2];
#pragma unroll
            for (int bj = 0; bj < 2; ++bj) { g[bj][0] = *(const f32x4*)(g1p + bj * 128); g[bj][1] = *(const f32x4*)(g1p + bj * 128 + 4); }
            bf16_t* xb = (bf16_t*)O0 + (size_t)(u.pm * 256 + rloc0) * 1024 + u.pn * 256 + cl;
#pragma unroll
            for (int ai = 0; ai < 2; ++ai) {
                u32x4 xq[4][2];
#pragma unroll
                for (int m = 0; m < 4; ++m)
#pragma unroll
                    for (int bj = 0; bj < 2; ++bj) xq[m][bj] = *(const u32x4*)(xb + (size_t)(ai * 128 + m * 16) * 1024 + bj * 128);
                asm volatile("" : "+v"(xq[0][0]), "+v"(xq[0][1]), "+v"(xq[1][0]), "+v"(xq[1][1]), "+v"(xq[2][0]), "+v"(xq[2][1]), "+v"(xq[3][0]), "+v"(xq[3][1]) :: "memory");
#pragma unroll
                for (int m = 0; m < 4; ++m)
#pragma unroll
                    for (int bj = 0; bj < 2; ++bj) { const u32x4 w = xq[m][bj]; const f32x4 a0 = acc[ai][bj][m][0], a1 = acc[ai][bj][m][1]; u32x4 o;
                        o.x = f2h(h2f(w.x & 0xffffu) + g[bj][0][0] * a0[0]) | (f2h(h2f(w.x >> 16) + g[bj][0][1] * a0[1]) << 16);
                        o.y = f2h(h2f(w.y & 0xffffu) + g[bj][0][2] * a0[2]) | (f2h(h2f(w.y >> 16) + g[bj][0][3] * a0[3]) << 16);
                        o.z = f2h(h2f(w.z & 0xffffu) + g[bj][1][0] * a1[0]) | (f2h(h2f(w.z >> 16) + g[bj][1][1] * a1[1]) << 16);
                        o.w = f2h(h2f(w.w & 0xffffu) + g[bj][1][2] * a1[2]) | (f2h(h2f(w.w >> 16) + g[bj][1][3] * a1[3]) << 16);
                        *(u32x4*)(xb + (size_t)(ai * 128 + m * 16) * 1024 + bj * 128) = o; }
            }
        } else if constexpr (KIND == K_MOE1) {
#pragma unroll
            for (int ai = 0; ai < 2; ++ai)
#pragma unroll
                for (int m = 0; m < 4; ++m) {
                    const int row = u.pm * 256 + rloc0 + ai * 128 + m * 16;
                    const f32x4 g0 = acc[ai][0][m][0], g1 = acc[ai][0][m][1], u0 = acc[ai][1][m][0], u1 = acc[ai][1][m][1];
                    float o[8];
#pragma unroll
                    for (int j = 0; j < 1; ++j) { const f32x4 s0 = silu_mul4(g0, u0), s1 = silu_mul4(g1, u1); o[0] = s0[0]; o[1] = s0[1]; o[2] = s0[2]; o[3] = s0[3]; o[4] = s1[0]; o[5] = s1[1]; o[6] = s1[2]; o[7] = s1[3]; }
                    u32x2 w; w.x = pack4_fp8(o[0], o[1], o[2], o[3]); w.y = pack4_fp8(o[4], o[5], o[6], o[7]);
                    *(u32x2*)((unsigned char*)O0 + (size_t)row * 1024 + u.pn * 128 + cl) = w;
                }
        } else {
#pragma unroll
            for (int ai = 0; ai < 2; ++ai)
#pragma unroll
                for (int m = 0; m < 4; ++m) {
                    const int rl = rloc0 + ai * 128 + m * 16, row = u.pm * 256 + rl;
                    float gs = 1.0f; if constexpr (KIND == K_MOE2 || I8) gs = __uint_as_float(tab[ui * 256 + rl]);
                    float ssq = 0.f;
#pragma unroll
                    for (int bj = 0; bj < 2; ++bj) {
                        f32x4 v0 = acc[ai][bj][m][0], v1 = acc[ai][bj][m][1];
                        if constexpr (I8) {
                            const float* wp = gvec + u.pn * 256 + bj * 128 + cl; const f32x4 s0 = *(const f32x4*)wp, s1 = *(const f32x4*)(wp + 4);
#pragma unroll
                            for (int j = 0; j < 4; ++j) { v0[j] = (float)__float_as_int(v0[j]) * (gs * s0[j]); v1[j] = (float)__float_as_int(v1[j]) * (gs * s1[j]); }
                        }
                        bf16_t* dst;
                        if constexpr (KIND == K_LRU_IN) {
                            if (u.pn < 5) {
#pragma unroll
                                for (int j = 0; j < 1; ++j) { v0 = gelu_fast4(v0); v1 = gelu_fast4(v1); }
                                dst = (bf16_t*)O0 + (size_t)row * 1280 + u.pn * 256 + bj * 128 + cl;
                            } else dst = O1 + (size_t)row * 1280 + (u.pn - 5) * 256 + bj * 128 + cl;
                        } else if constexpr (KIND == K_SG_IN) {
#pragma unroll
                            for (int j = 0; j < 1; ++j) { v0 = gelu_fast4(v0); v1 = gelu_fast4(v1); const f32x4 sq = v0 * v0 + v1 * v1; ssq += (sq[0] + sq[1]) + (sq[2] + sq[3]); }
                            dst = (bf16_t*)O0 + (size_t)row * 4096 + u.pn * 256 + bj * 128 + cl;
                        } else if constexpr (KIND == K_MOE2) {
                            v0 = v0 * (gs * 16.0f); v1 = v1 * (gs * 16.0f);
                            u32x2 w8; w8.x = pack4_fp8(v0[0], v0[1], v0[2], v0[3]); w8.y = pack4_fp8(v1[0], v1[1], v1[2], v1[3]);
                            *(u32x2*)((unsigned char*)O0 + (size_t)row * 1024 + u.pn * 256 + bj * 128 + cl) = w8;
                            continue;
                        } else dst = (bf16_t*)O0 + (size_t)row * 1024 + u.pn * 256 + bj * 128 + cl;
                        u32x4 w; w.x = cvt_pk_bf16(v0[0], v0[1]); w.y = cvt_pk_bf16(v0[2], v0[3]); w.z = cvt_pk_bf16(v1[0], v1[1]); w.w = cvt_pk_bf16(v1[2], v1[3]);
                        *(u32x4*)dst = w;
                    }
                    if constexpr (KIND == K_SG_IN) {
                        if (u.pn >= 8) { ssq += shx(ssq, 16, lane); ssq += shx(ssq, 32, lane); if (fq == 0) vss[(size_t)row * 32 + (u.pn - 8) * 4 + wc] = ssq; }
                    }
                }
        }
    }
};

template <class Pr>
__device__ __forceinline__ void gemm_phase(LAS unsigned char* lds, const Pr& pr, int wv) {
    constexpr int ROWB = Pr::ROWB, nt = ROWB / (BK * 2); constexpr bool FP8 = Pr::FP8;
    const Ids I = fresh_ids(wv); const int tid = I.tid, wid = I.wid, lane = I.lane, wr = wid >> 2, wc = wid & 3, fr = lane & 15, fq = lane >> 4;
    int R[2], C[2]; unsigned voffB[2];
#pragma unroll
    for (int i = 0; i < 2; ++i) { stage_rc(tid * 16 + i * 8192, R[i], C[i]); const int Rb = (R[i] & ~31) + perm32(R[i] & 31); voffB[i] = (unsigned)Rb * (unsigned)ROWB + (unsigned)(C[i] * 2); }
    const unsigned ldsw = (unsigned)wid * 1024u;
    const int aoff = lds_byte(wr * 64 + fr, fq * 8), boff = lds_byte(wc * 32 + fr, fq * 8);
#define PG8_SA(b, h) (((b) * 2 + (h)) * HTB)
#define PG8_SB(b, h) ((4 + (b) * 2 + (h)) * HTB)
#define PG8_STAGE(bufoff, gbase, voff) do { LAS unsigned char* lb_ = lds + ldsw; asm volatile("" : "+s"(lb_));     \
        _Pragma("unroll") for (int _i = 0; _i < 2; ++_i) \
        __builtin_amdgcn_global_load_lds((const unsigned*)((const char*)(gbase) + (voff)[_i]), (LAS unsigned*)(lb_ + (bufoff) + _i * 8192), 16, 0, 0); } while (0)
#define PG8_LD8(off_) ({ const i32x4 lo_ = *(const LAS i32x4*)(lds + (off_)); const i32x4 hi_ = *(const LAS i32x4*)(lds + (off_) + 1024); __builtin_shufflevector(lo_, hi_, 0, 1, 2, 3, 4, 5, 6, 7); })
#define PG8_LDA8(dst, b, h) do { _Pragma("unroll") for (int m = 0; m < 4; ++m) dst[m] = PG8_LD8(PG8_SA(b, h) + aoff + m * 2048); } while (0)
#define PG8_LDB8(dst, b, h) do { _Pragma("unroll") for (int n = 0; n < 2; ++n) dst[n] = PG8_LD8(PG8_SB(b, h) + boff + n * 2048); } while (0)
#define PG8_MMA8(ai, bj, At, Bt) do { __builtin_amdgcn_s_setprio(1); _Pragma("unroll") for (int m = 0; m < 4; ++m) _Pragma("unroll") for (int n = 0; n < 2; ++n) \
        asm volatile("v_mfma_scale_f32_16x16x128_f8f6f4 %0, %1, %2, %0, %3, %4 op_sel_hi:[0,0,0]" : "+v"(acc[ai][bj][m][n]) : "v"(Bt[n]), "v"(At[m]), "v"(sclW), "v"(sclX)); __builtin_amdgcn_s_setprio(0); } while (0)
#define PG8_LDA(dst, b, h) do { _Pragma("unroll") for (int m = 0; m < 4; ++m) _Pragma("unroll") for (int k = 0; k < 2; ++k) dst[m][k] = *(const LAS bf16x8*)(lds + PG8_SA(b, h) + aoff + m * 2048 + k * 1024); } while (0)
#define PG8_LDB(dst, b, h) do { _Pragma("unroll") for (int n = 0; n < 2; ++n) _Pragma("unroll") for (int k = 0; k < 2; ++k) dst[n][k] = *(const LAS bf16x8*)(lds + PG8_SB(b, h) + boff + n * 2048 + k * 1024); } while (0)
#define PG8_MMA(ai, bj, At, Bt) do { __builtin_amdgcn_s_setprio(1); _Pragma("unroll") for (int m = 0; m < 4; ++m) _Pragma("unroll") for (int n = 0; n < 2; ++n) _Pragma("unroll") for (int k = 0; k < 2; ++k) \
        acc[ai][bj][m][n] = __builtin_amdgcn_mfma_f32_16x16x32_bf16(Bt[n][k], At[m][k], acc[ai][bj][m][n], 0, 0, 0); __builtin_amdgcn_s_setprio(0); } while (0)
#define PG8_WAIT_V(n) asm volatile("s_waitcnt vmcnt(" #n ")" ::: "memory")
#define PG8_WAIT_L(n) asm volatile("s_waitcnt lgkmcnt(" #n ")" ::: "memory")
#define PG8_BAR __builtin_amdgcn_s_barrier()
#define PG8_SCHED __builtin_amdgcn_sched_barrier(0)
    pr.prep(tid);
    Unit cur, nxt; int ui = 0;
    if (!pr.next(0, cur)) return;
    f32x4 acc[2][2][4][2];
#pragma unroll
    for (int a = 0; a < 2; ++a)
#pragma unroll
        for (int b = 0; b < 2; ++b)
#pragma unroll
            for (int m = 0; m < 4; ++m)
#pragma unroll
                for (int n = 0; n < 2; ++n) acc[a][b][m][n] = (f32x4){0.f, 0.f, 0.f, 0.f};
    bf16x8 At[4][2], B0[2][2], B1[2][2]; i32x8 At8[4], B08[2], B18[2];
    const int sclW = 0x7a7a7a7a, sclX = 0x7f7f7f7f;
#define PG8_XLDA(b, h) do { if constexpr (FP8) PG8_LDA8(At8, b, h); else PG8_LDA(At, b, h); } while (0)
#define PG8_XLDB0(b, h) do { if constexpr (FP8) PG8_LDB8(B08, b, h); else PG8_LDB(B0, b, h); } while (0)
#define PG8_XLDB1(b, h) do { if constexpr (FP8) PG8_LDB8(B18, b, h); else PG8_LDB(B1, b, h); } while (0)
#define PG8_MMAI(ai, bj, At, Bt) do { __builtin_amdgcn_s_setprio(1); _Pragma("unroll") for (int m = 0; m < 4; ++m) _Pragma("unroll") for (int n = 0; n < 2; ++n) _Pragma("unroll") for (int k = 0; k < 2; ++k) \
        asm volatile("v_mfma_i32_16x16x64_i8 %0, %1, %2, %0" : "+v"(acc[ai][bj][m][n]) : "v"(Bt[n][k]), "v"(At[m][k])); __builtin_amdgcn_s_setprio(0); } while (0)
#define PG8_XMMA0(ai, bj) do { if constexpr (FP8) PG8_MMA8(ai, bj, At8, B08); else if constexpr (Pr::I8) PG8_MMAI(ai, bj, At, B0); else PG8_MMA(ai, bj, At, B0); } while (0)
#define PG8_XMMA1(ai, bj) do { if constexpr (FP8) PG8_MMA8(ai, bj, At8, B18); else if constexpr (Pr::I8) PG8_MMAI(ai, bj, At, B1); else PG8_MMA(ai, bj, At, B1); } while (0)
    const char* const Ab = (const char*)pr.A;
    unsigned cA[2][2], nA[2][2];
    pr.a_off(cur, 0, R, C, cA);
    const char* cB0 = pr.b_half(cur, 0); const char* cB1 = pr.b_half(cur, 1);
    constexpr unsigned kstep = BK * 2;
    PG8_STAGE(PG8_SB(0, 0), cB0, voffB); PG8_STAGE(PG8_SB(0, 1), cB1, voffB); PG8_STAGE(PG8_SA(0, 0), Ab, cA[0]); PG8_STAGE(PG8_SA(0, 1), Ab, cA[1]);
    if (wr == 1) PG8_BAR;
    PG8_WAIT_V(2); PG8_BAR;
    PG8_STAGE(PG8_SB(1, 0), cB0 + kstep, voffB); PG8_STAGE(PG8_SA(1, 0), Ab + kstep, cA[0]); PG8_STAGE(PG8_SB(1, 1), cB1 + kstep, voffB);
    PG8_WAIT_V(6); PG8_BAR;
    for (;;) {
        const bool has_next = pr.next(ui + 1, nxt);
        const char* nB0 = cB0; const char* nB1 = cB1;
        unsigned dA = 0u;
        if (has_next) { nB0 = pr.b_half(nxt, 0); nB1 = pr.b_half(nxt, 1);
            if constexpr (Pr::GATHER) pr.a_off(nxt, ui + 1, R, C, nA); else dA = (unsigned)((nxt.pm - cur.pm) * 256) * (unsigned)ROWB; }
        else if constexpr (Pr::GATHER) {
#pragma unroll
            for (int h = 0; h < 2; ++h)
#pragma unroll
                for (int i = 0; i < 2; ++i) nA[h][i] = cA[h][i];
        }
#pragma unroll 1
        for (int t = 0; t < nt; t += 2) {
            const bool last = (t == nt - 2);
            const unsigned k1 = (unsigned)(t + 1) * kstep, k2 = last ? 0u : (unsigned)(t + 2) * kstep, k3 = k2 + kstep;
            unsigned s2[2][2];
#pragma unroll
            for (int h = 0; h < 2; ++h)
#pragma unroll
                for (int i = 0; i < 2; ++i) { if constexpr (Pr::GATHER) s2[h][i] = last ? nA[h][i] : cA[h][i]; else s2[h][i] = cA[h][i] + (last ? dA : 0u); }
            const char* b20 = (last ? nB0 : cB0) + k2; const char* b21 = (last ? nB1 : cB1) + k2;
            PG8_XLDB0(0, 0); PG8_XLDB1(0, 1); PG8_SCHED; PG8_XLDA(0, 0); PG8_STAGE(PG8_SA(1, 1), Ab + k1, cA[1]);
            PG8_WAIT_V(8); PG8_WAIT_L(0); PG8_BAR; PG8_XMMA0(0, 0); PG8_XMMA1(0, 1); PG8_BAR; PG8_SCHED;
            PG8_XLDA(0, 1); PG8_STAGE(PG8_SB(0, 0), b20, voffB); PG8_STAGE(PG8_SB(0, 1), b21, voffB); PG8_STAGE(PG8_SA(0, 0), Ab + k2, s2[0]);
            PG8_WAIT_V(8); PG8_WAIT_L(0); PG8_BAR; PG8_XMMA0(1, 0); PG8_XMMA1(1, 1); PG8_BAR; PG8_SCHED;
            PG8_XLDB0(1, 0); PG8_XLDB1(1, 1); PG8_SCHED; PG8_XLDA(1, 0); PG8_STAGE(PG8_SA(0, 1), Ab + k2, s2[1]);
            PG8_WAIT_V(8); PG8_WAIT_L(0); PG8_BAR; PG8_XMMA0(0, 0); PG8_XMMA1(0, 1); PG8_BAR; PG8_SCHED;
            PG8_XLDA(1, 1); PG8_STAGE(PG8_SB(1, 0), b20 + kstep, voffB); PG8_STAGE(PG8_SB(1, 1), b21 + kstep, voffB); PG8_STAGE(PG8_SA(1, 0), Ab + k3, s2[0]);
            PG8_WAIT_V(8); PG8_WAIT_L(0); PG8_BAR; PG8_XMMA0(1, 0); PG8_XMMA1(1, 1); PG8_BAR; PG8_SCHED;
        }
        if (wr == 0) PG8_BAR;
        pr.epi(acc, cur, ui, wr, wc, fr, fq);
        if (!has_next) break;
#pragma unroll
        for (int a = 0; a < 2; ++a)
#pragma unroll
            for (int b = 0; b < 2; ++b)
#pragma unroll
                for (int m = 0; m < 4; ++m)
#pragma unroll
                    for (int n = 0; n < 2; ++n) acc[a][b][m][n] = (f32x4){0.f, 0.f, 0.f, 0.f};
        cur = nxt; cB0 = nB0; cB1 = nB1; ++ui;
#pragma unroll
        for (int h = 0; h < 2; ++h)
#pragma unroll
            for (int i = 0; i < 2; ++i) { if constexpr (Pr::GATHER) cA[h][i] = nA[h][i]; else cA[h][i] += dA; }
        if (wr == 1) PG8_BAR;
    }
    PG8_WAIT_V(0);
    PG8_BAR;
#undef PG8_SA
#undef PG8_SB
#undef PG8_STAGE
#undef PG8_LDA
#undef PG8_LD8
#undef PG8_LDA8
#undef PG8_LDB8
#undef PG8_MMA8
#undef PG8_XLDA
#undef PG8_XLDB0
#undef PG8_XLDB1
#undef PG8_XMMA0
#undef PG8_MMAI
#undef PG8_XMMA1
#undef PG8_LDB
#undef PG8_MMA
#undef PG8_WAIT_V
#undef PG8_WAIT_L
#undef PG8_BAR
#undef PG8_SCHED
}
}


__device__ __forceinline__ unsigned pk2(float lo, float hi) { unsigned r; asm("v_cvt_pk_bf16_f32 %0, %1, %2" : "=v"(r) : "v"(lo), "v"(hi)); return r; }
__device__ __forceinline__ void transpose_item(const float* W, int K, int N, bf16_t* WT, LAS float* scr, int item, int lane) {
    const int nblk = N / 32, kb = item / nblk, nb = item % nblk, k0 = 64 * kb, n0 = 32 * nb;
#pragma unroll 8
    for (int i = 0; i < 32; ++i) { const int kk = 2 * i + (lane >> 5); scr[kk * 33 + (lane & 31)] = W[(size_t)(k0 + kk) * N + n0 + (lane & 31)]; }
    asm volatile("s_waitcnt lgkmcnt(0)" ::: "memory");
    const int c = lane & 7;
#pragma unroll
    for (int j = 0; j < 4; ++j) { const int n = (lane >> 3) + 8 * j; const LAS float* s = scr + (8 * c) * 33 + n;
        u32x4 o; o.x = pk2(s[0 * 33], s[1 * 33]); o.y = pk2(s[2 * 33], s[3 * 33]); o.z = pk2(s[4 * 33], s[5 * 33]); o.w = pk2(s[6 * 33], s[7 * 33]);
        *(u32x4*)(WT + (size_t)(n0 + n) * K + k0 + 8 * c) = o; }
    asm volatile("s_waitcnt lgkmcnt(0)" ::: "memory");
}

__device__ __forceinline__ void cv8_load(const float* W, int N, int item, int nblk, int lane, f32x4 (&v)[8]) {
    const int kb = item / nblk, nb = item - kb * nblk; const float* src = W + (size_t)(64 * kb + (lane >> 3)) * N + 32 * nb + (lane & 7) * 4;
#pragma unroll
    for (int i = 0; i < 8; ++i) v[i] = *(const f32x4*)(src + (size_t)(8 * i) * N);
}
__device__ __forceinline__ void cv8_emit(const f32x4 (&v)[8], int K, int N, unsigned char* WT, LAS float* scr, int item, int nblk, int lane) {
    const int kb = item / nblk, nb = item - kb * nblk, k0 = 64 * kb, n0 = 32 * nb;
    { LAS float* d = scr + (lane >> 3) * 33 + (lane & 7) * 4;
#pragma unroll
      for (int i = 0; i < 8; ++i) { d[(8 * i) * 33 + 0] = v[i][0]; d[(8 * i) * 33 + 1] = v[i][1]; d[(8 * i) * 33 + 2] = v[i][2]; d[(8 * i) * 33 + 3] = v[i][3]; } }
    asm volatile("s_waitcnt lgkmcnt(0)" ::: "memory");
    const int c = lane & 3;
#pragma unroll
    for (int jj = 0; jj < 2; ++jj) { const int n = (lane >> 2) + 16 * jj; const LAS float* sp = scr + (16 * c) * 33 + n;
        u32x4 o;
        o.x = pg8::pack4_fp8(32.f * sp[0 * 33], 32.f * sp[1 * 33], 32.f * sp[2 * 33], 32.f * sp[3 * 33]);     o.y = pg8::pack4_fp8(32.f * sp[4 * 33], 32.f * sp[5 * 33], 32.f * sp[6 * 33], 32.f * sp[7 * 33]);
        o.z = pg8::pack4_fp8(32.f * sp[8 * 33], 32.f * sp[9 * 33], 32.f * sp[10 * 33], 32.f * sp[11 * 33]);   o.w = pg8::pack4_fp8(32.f * sp[12 * 33], 32.f * sp[13 * 33], 32.f * sp[14 * 33], 32.f * sp[15 * 33]);
        *(u32x4*)(WT + (size_t)(n0 + n) * K + k0 + 16 * c) = o; }
    asm volatile("s_waitcnt lgkmcnt(0)" ::: "memory");
}


__device__ __forceinline__ void cvb_emit(const f32x4 (&v)[8], int K, bf16_t* WT, LAS float* scr, int item, int nblk, int lane) {
    const int kb = item / nblk, nb = item - kb * nblk, k0 = 64 * kb, n0 = 32 * nb;
    { LAS float* d = scr + (lane >> 3) * 33 + (lane & 7) * 4;
#pragma unroll
      for (int i = 0; i < 8; ++i) { d[(8 * i) * 33 + 0] = v[i][0]; d[(8 * i) * 33 + 1] = v[i][1]; d[(8 * i) * 33 + 2] = v[i][2]; d[(8 * i) * 33 + 3] = v[i][3]; } }
    asm volatile("s_waitcnt lgkmcnt(0)" ::: "memory");
    const int c = lane & 7;
#pragma unroll
    for (int j = 0; j < 4; ++j) { const int n = (lane >> 3) + 8 * j; const LAS float* s = scr + (8 * c) * 33 + n;
        u32x4 o; o.x = pk2(s[0 * 33], s[1 * 33]); o.y = pk2(s[2 * 33], s[3 * 33]); o.z = pk2(s[4 * 33], s[5 * 33]); o.w = pk2(s[6 * 33], s[7 * 33]);
        *(u32x4*)(WT + (size_t)(n0 + n) * K + k0 + 8 * c) = o; }
    asm volatile("s_waitcnt lgkmcnt(0)" ::: "memory");
}

__device__ __forceinline__ unsigned pack4_i8(float a, float b, float c, float d) {
    return ((unsigned)(int)__builtin_rintf(a) & 0xffu) | (((unsigned)(int)__builtin_rintf(b) & 0xffu) << 8) | (((unsigned)(int)__builtin_rintf(c) & 0xffu) << 16) | (((unsigned)(int)__builtin_rintf(d) & 0xffu) << 24);
}
__device__ __forceinline__ void transpose_item_i8(const float* W, int K, int N, signed char* WT, float* wsc, const float* wpm, int NC, LAS float* scr, int item, int lane) {
    const int nblk = N / 32, kb = item / nblk, nb = item % nblk, k0 = 64 * kb, n0 = 32 * nb;
#pragma unroll 8
    for (int i = 0; i < 32; ++i) { const int kk = 2 * i + (lane >> 5); scr[kk * 33 + (lane & 31)] = W[(size_t)(k0 + kk) * N + n0 + (lane & 31)]; }
    asm volatile("s_waitcnt lgkmcnt(0)" ::: "memory");
    const int c = lane & 3;
#pragma unroll
    for (int jj = 0; jj < 2; ++jj) { const int n = (lane >> 2) + 16 * jj; const LAS float* sp = scr + (16 * c) * 33 + n;
        float mx = 0.f;
#pragma unroll
        for (int q = 0; q < 16; ++q) mx = fmaxf(mx, wpm[(size_t)q * NC + n0 + n]);
        const float sv = mx * (1.0f / 127.0f); const float inv = sv > 0.f ? 1.0f / sv : 0.f;
        if (kb == 0 && c == 0) wsc[n0 + n] = sv;
        u32x4 o;
        o.x = pack4_i8(inv * sp[0 * 33], inv * sp[1 * 33], inv * sp[2 * 33], inv * sp[3 * 33]);     o.y = pack4_i8(inv * sp[4 * 33], inv * sp[5 * 33], inv * sp[6 * 33], inv * sp[7 * 33]);
        o.z = pack4_i8(inv * sp[8 * 33], inv * sp[9 * 33], inv * sp[10 * 33], inv * sp[11 * 33]);   o.w = pack4_i8(inv * sp[12 * 33], inv * sp[13 * 33], inv * sp[14 * 33], inv * sp[15 * 33]);
        *(u32x4*)(WT + (size_t)(n0 + n) * K + k0 + 16 * c) = o; }
    asm volatile("s_waitcnt lgkmcnt(0)" ::: "memory");
}
__device__ __forceinline__ void cvt_i8_seg(const float* W, signed char* WT, float* wsc, const float* wpm, int K, int N, int nmat, LAS float* scr, int gw, int ngw, int lane) {
    const int per = (K / 64) * (N / 32), total = per * nmat;
    for (int it = gw; it < total; it += ngw) { const int mi = it / per; transpose_item_i8(W + (size_t)mi * K * N, K, N, WT + (size_t)mi * K * N, wsc + (size_t)mi * N, wpm + (size_t)mi * N, N * nmat, scr, it - mi * per, lane); }
}
__device__ __forceinline__ void colscale_seg(const float* W, float* wpm, int K, int N, int nmat, int gtid, int ngt) {
    const int NC = N * nmat;
    for (int idx = gtid; idx < NC * (K / 64); idx += ngt) { const int ksp = idx / NC, cix = idx - ksp * NC, mi = cix / N, n = cix - mi * N; const float* w = W + ((size_t)mi * K + (size_t)ksp * 64) * N + n; float mx = 0.f;
        for (int k0 = 0; k0 < 64; k0 += 16) { float v[16];
#pragma unroll
            for (int u = 0; u < 16; ++u) v[u] = w[(size_t)(k0 + u) * N];
#pragma unroll
            for (int u = 0; u < 16; ++u) mx = fmaxf(mx, fabsf(v[u])); }
        wpm[idx] = mx; }
}

__device__ __forceinline__ void cvt_i8_panels(const float* W, signed char* WT, float* wsc, LAS unsigned char* lds, int bid, int G, int tid) {
    LAS float* tile = (LAS float*)lds;
    LAS float* cmx = tile + 1024 * 33;
    for (int panel = bid; panel < 256; panel += G) {
        const int mi = panel >> 7, n0 = (panel & 127) * 32, cc = tid & 31, rr = tid >> 5;
        const float* src = W + (size_t)mi * 1024 * 4096 + n0 + cc;
        for (int r0 = 0; r0 < 1024; r0 += 256) {
            float v[16];
#pragma unroll
            for (int u = 0; u < 16; ++u) v[u] = src[(size_t)(r0 + u * 16 + rr) * 4096];
#pragma unroll
            for (int u = 0; u < 16; ++u) tile[(r0 + u * 16 + rr) * 33 + cc] = v[u];
        }
        __syncthreads();
        { float mx = 0.f;
#pragma unroll 16
          for (int u = 0; u < 64; ++u) mx = fmaxf(mx, fabsf(tile[(rr * 64 + u) * 33 + cc]));
          cmx[rr * 32 + cc] = mx; }
        __syncthreads();
        if (tid < 32) { float mx = 0.f;
#pragma unroll
            for (int q = 0; q < 16; ++q) mx = fmaxf(mx, cmx[q * 32 + tid]);
            const float sv = mx * (1.0f / 127.0f); cmx[512 + tid] = sv; wsc[(size_t)mi * 4096 + n0 + tid] = sv; }
        __syncthreads();
        { const float sv = cmx[512 + cc]; const float inv = sv > 0.f ? 1.0f / sv : 0.f;
          signed char* dst = WT + ((size_t)mi * 4096 + n0 + cc) * 1024;
#pragma unroll
          for (int j = 0; j < 4; ++j) { const int ck = rr + 16 * j; const LAS float* sp = tile + (16 * ck) * 33 + cc;
              u32x4 o;
              o.x = pack4_i8(inv * sp[0 * 33], inv * sp[1 * 33], inv * sp[2 * 33], inv * sp[3 * 33]);     o.y = pack4_i8(inv * sp[4 * 33], inv * sp[5 * 33], inv * sp[6 * 33], inv * sp[7 * 33]);
              o.z = pack4_i8(inv * sp[8 * 33], inv * sp[9 * 33], inv * sp[10 * 33], inv * sp[11 * 33]);   o.w = pack4_i8(inv * sp[12 * 33], inv * sp[13 * 33], inv * sp[14 * 33], inv * sp[15 * 33]);
              *(u32x4*)(dst + 16 * ck) = o; } }
        __syncthreads();
    }
}

typedef float f32x16 __attribute__((ext_vector_type(16)));
constexpr int XB_STRIDE = 272, XB_BYTES = 256 * XB_STRIDE, HF_STRIDE = 260, HF_BYTES = 256 * HF_STRIDE;
constexpr int NCK128 = NTOK / 128;
struct LruW { const bf16_t* wt_a; const bf16_t* wt_x; };

template <int D> __device__ __forceinline__ void lru_dir(const P& p, const LruW& W, int jl, int h, int row0, LAS unsigned char* xb, LAS unsigned char* hfb, int wn, int wm, int c, int q, int lane) {
    const int j = 32 * wn + c, ch = h * 128 + j;
    const float ba = p.lru_b_a[(jl * 2 + D) * LW + ch], bx = p.lru_b_x[(jl * 2 + D) * LW + ch];
    const float k2 = p.k2tab[(jl * 2 + D) * LW + ch];
    const float nba = -1.44269504089f * ba, nbx = -1.44269504089f * bx;
    bf16x8 Ba[8], Bx[8];
    {
        const bf16_t* ga = W.wt_a + ((size_t)((jl * 2 + D) * 10 + h) * 128 + j) * 128 + 8 * q;
        const bf16_t* gx = W.wt_x + ((size_t)((jl * 2 + D) * 10 + h) * 128 + j) * 128 + 8 * q;
#pragma unroll
        for (int s = 0; s < 8; ++s) { Ba[s] = *(const bf16x8*)(ga + 16 * s); Bx[s] = *(const bf16x8*)(gx + 16 * s); }
    }
    float Hc = 0.f, Cc = 1.f;
    const bool first = (D == 0) ? (q == 0) : (q == 1);
    for (int mi = 0; mi < 4; ++mi) {
        const int m = (D == 0) ? mi : 3 - mi;
        f32x16 aa, ax;
#pragma unroll
        for (int r = 0; r < 16; ++r) { aa[r] = 0.f; ax[r] = 0.f; }
        const LAS unsigned char* arow = xb + (wm * 128 + m * 32 + (lane & 31)) * XB_STRIDE + 16 * q;
#pragma unroll
        for (int s = 0; s < 8; ++s) {
            const bf16x8 af = *(const LAS bf16x8*)(arow + 32 * s);
            aa = __builtin_amdgcn_mfma_f32_32x32x16_bf16(af, Ba[s], aa, 0, 0, 0);
            ax = __builtin_amdgcn_mfma_f32_32x32x16_bf16(af, Bx[s], ax, 0, 0, 0);
        }
        const LAS unsigned char* xcol = xb + (wm * 128 + m * 32 + 4 * q) * XB_STRIDE + j * 2;
        float hL = 0.f, cL = 1.f;
#pragma unroll
        for (int rr = 0; rr < 16; rr += 2) {
            const int rl = (D == 0) ? rr : 14 - rr;
            f32x2 xv2, za, zx;
#pragma unroll
            for (int t2 = 0; t2 < 2; ++t2) { const int r = rl + t2, i0 = (r & 3) + 8 * (r >> 2);
                xv2[t2] = __uint_as_float(((unsigned)*(const LAS unsigned short*)(xcol + i0 * XB_STRIDE)) << 16); za[t2] = aa[r]; zx[t2] = ax[r]; }
            const f32x2 nl2 = {-1.44269504089f, -1.44269504089f};
            za = __builtin_elementwise_fma(za, nl2, (f32x2){nba, nba});
            zx = __builtin_elementwise_fma(zx, nl2, (f32x2){nbx, nbx});
            f32x2 da, dx; da[0] = __builtin_amdgcn_exp2f(za[0]); da[1] = __builtin_amdgcn_exp2f(za[1]); dx[0] = __builtin_amdgcn_exp2f(zx[0]); dx[1] = __builtin_amdgcn_exp2f(zx[1]);
            da = da + 1.0f; dx = dx + 1.0f;
            f32x2 rg, ig; rg[0] = __builtin_amdgcn_rcpf(da[0]); rg[1] = __builtin_amdgcn_rcpf(da[1]); ig[0] = __builtin_amdgcn_rcpf(dx[0]); ig[1] = __builtin_amdgcn_rcpf(dx[1]);
            const f32x2 l2 = rg * k2;
            f32x2 a2; a2[0] = __builtin_amdgcn_exp2f(l2[0]); a2[1] = __builtin_amdgcn_exp2f(l2[1]);
            const f32x2 om = __builtin_elementwise_fma(-a2, a2, (f32x2){1.0f, 1.0f});
            f32x2 sq; sq[0] = __builtin_amdgcn_sqrtf(om[0]); sq[1] = __builtin_amdgcn_sqrtf(om[1]);
            const f32x2 u2 = sq * (ig * xv2);
#pragma unroll
            for (int t2 = 0; t2 < 2; ++t2) { const int q2 = (D == 0) ? t2 : 1 - t2, r = rl + q2;
                hL = a2[q2] * hL + u2[q2]; cL *= a2[q2];
                ax[r] = hL; aa[r] = cL; }
        }
        const float Ao = shx(cL, 32, lane), Ho = shx(hL, 32, lane);
        const float A_f = first ? cL : Ao, H_f = first ? hL : Ho, A_s = first ? Ao : cL, H_s = first ? Ho : hL;
        const float mid = A_f * Hc + H_f;
        const float cin = first ? Hc : mid, cpre = first ? Cc : Cc * A_f;
        Hc = A_s * mid + H_s; Cc = Cc * A_f * A_s;
        const int trow = wm * 128 + m * 32 + q * 16;
        const int odd = lane & 1;
        unsigned char* gA = ((D == 0) ? p.Af : p.Ab) + (size_t)(row0 + trow + odd) * LW + (ch - odd);
        bf16_t* gS = p.S + (size_t)(row0 + trow) * LW + ch;
        LAS unsigned char* hrow = hfb + trow * HF_STRIDE + j * 2;
        const float cpre255 = cpre * 255.0f;
#pragma unroll
        for (int r = 0; r < 16; r += 2) {
            const float cv0 = __builtin_rintf(aa[r] * cpre255), cv1 = __builtin_rintf(aa[r + 1] * cpre255);
            const float send = odd ? cv0 : cv1; const float recv = __int_as_float(__builtin_amdgcn_mov_dpp(__float_as_int(send), 0xB1, 0xF, 0xF, true));
            unsigned pk = __builtin_amdgcn_cvt_pk_u8_f32(odd ? recv : cv0, 0, 0u); pk = __builtin_amdgcn_cvt_pk_u8_f32(odd ? cv1 : recv, 1, pk);
            *(unsigned short*)(gA + (size_t)r * LW) = (unsigned short)pk;
        }
#pragma unroll
        for (int r = 0; r < 16; ++r) {
            const float hv = ax[r] + aa[r] * cin;
            if (D == 0) *(LAS unsigned short*)(hrow + r * HF_STRIDE) = f2bf(hv);
            else { const float hf = __uint_as_float(((unsigned)*(const LAS unsigned short*)(hrow + r * HF_STRIDE)) << 16); gS[(size_t)r * LW] = f2bf(hv + hf); }
        }
    }
    if (q == 0) { const int ck128 = (row0 >> 7) + wm; float* ag = p.agg + ((size_t)(ck128 * 2 + D) * 2) * LW + ch; ag[0] = Cc; ag[LW] = Hc; }
}

__device__ __forceinline__ void lru_scan_phase(const P& p, const LruW& W, int jl, LAS unsigned char* lds, int wv) {
    const Ids I = fresh_ids(wv); const int tid = I.tid, lane = I.lane, wid = I.wid, wn = wid & 3, wm = wid >> 2, c = lane & 31, q = lane >> 5;
    LAS unsigned char* xb = lds; LAS unsigned char* hfb = lds + XB_BYTES;
    for (int u = I.bid; u < NCK * 10; u += I.G) {
        const int ck = u / 10, h = u - ck * 10, row0 = ck * 256;
        int t0, T; if (ck < 32) { t0 = 0; T = 256; } else { t0 = ((ck - 32) & 15) * 256; T = 4096; }
        {
            const int chunk = tid & 15, g = tid >> 4, ch0 = h * 128 + chunk * 8;
            const float* cw = p.lru_conv_w + (size_t)jl * 4 * LW + ch0; const float* cbp = p.lru_conv_b + jl * LW + ch0;
            float w[4][8], b[8];
#pragma unroll
            for (int k = 0; k < 4; ++k) { const float4 lo = *(const float4*)(cw + k * LW), hi = *(const float4*)(cw + k * LW + 4); w[k][0] = lo.x; w[k][1] = lo.y; w[k][2] = lo.z; w[k][3] = lo.w; w[k][4] = hi.x; w[k][5] = hi.y; w[k][6] = hi.z; w[k][7] = hi.w; }
            { const float4 lo = *(const float4*)cbp, hi = *(const float4*)(cbp + 4); b[0] = lo.x; b[1] = lo.y; b[2] = lo.z; b[3] = lo.w; b[4] = hi.x; b[5] = hi.y; b[6] = hi.z; b[7] = hi.w; }
            uint4 raw[11];
#pragma unroll
            for (int k = 0; k < 11; ++k) { const int tl = g * 8 + k - 2, tt = t0 + tl; raw[k] = make_uint4(0u, 0u, 0u, 0u);
                if (tt >= 0 && tt < T) raw[k] = *(const uint4*)(p.xpre + (size_t)(row0 + tl) * LW + ch0); }
            asm volatile("" ::: "memory");
#pragma unroll
            for (int k = 0; k < 8; ++k) {
                float o[8];
#pragma unroll
                for (int e = 0; e < 8; ++e) o[e] = b[e];
#pragma unroll
                for (int tap = 0; tap < 4; ++tap) { const uint4 rw = raw[k + tap]; const unsigned ww[4] = {rw.x, rw.y, rw.z, rw.w};
#pragma unroll
                    for (int e2 = 0; e2 < 4; ++e2) { o[2 * e2] += w[tap][2 * e2] * __uint_as_float(ww[e2] << 16); o[2 * e2 + 1] += w[tap][2 * e2 + 1] * __uint_as_float(ww[e2] & 0xffff0000u); } }
                const int Tt = g * 8 + k, wmm = Tt >> 7, tl = Tt & 127, mm = tl >> 5, qq = (tl >> 4) & 1, r = tl & 15, i = (r & 3) + 8 * (r >> 2) + 4 * qq;
                u32x4 pk; pk.x = pk2(o[0], o[1]); pk.y = pk2(o[2], o[3]); pk.z = pk2(o[4], o[5]); pk.w = pk2(o[6], o[7]);
                *(LAS u32x4*)(xb + (wmm * 128 + mm * 32 + i) * XB_STRIDE + chunk * 16) = pk;
            }
        }
        __syncthreads();
        lru_dir<0>(p, W, jl, h, row0, xb, hfb, wn, wm, c, q, lane);
        lru_dir<1>(p, W, jl, h, row0, xb, hfb, wn, wm, c, q, lane);
        __syncthreads();
    }
}
__device__ __forceinline__ void lru_fix_phase(const P& p, int jl, int wv) {
    const Ids I = fresh_ids(wv);
    for (int it = I.bid * 512 + I.tid; it < NCK128 * 4 * 160; it += I.G * 512) {
        const int cg = it % 160, rq = (it / 160) & 3, ck = it / 640, ch0 = cg * 8;
        int seq, pos, nch, base; bool smp = ck >= 64;
        if (!smp) { seq = ck >> 1; pos = ck & 1; nch = 2; base = seq * 2; } else { const int c2 = ck - 64; seq = c2 >> 5; pos = c2 & 31; nch = 32; base = 64 + seq * 32; }
        float cf[8], cb[8];
#pragma unroll
        for (int e = 0; e < 8; ++e) { cf[e] = 0.f; cb[e] = 0.f; }
        if (smp) { const float* s0 = p.state_lru + ((size_t)(seq * 2 + jl) * 2) * LW + ch0;
#pragma unroll
            for (int e = 0; e < 8; ++e) { cf[e] = s0[e]; cb[e] = s0[LW + e]; } }
        for (int k = 0; k < pos; ++k) { const float* a = p.agg + ((size_t)((base + k) * 2 + 0) * 2) * LW + ch0;
#pragma unroll
            for (int e = 0; e < 8; ++e) cf[e] = a[e] * cf[e] + a[LW + e]; }
        for (int k = nch - 1; k > pos; --k) { const float* a = p.agg + ((size_t)((base + k) * 2 + 1) * 2) * LW + ch0;
#pragma unroll
            for (int e = 0; e < 8; ++e) cb[e] = a[e] * cb[e] + a[LW + e]; }
        if (!smp && rq == 0) {
            const float* a = p.agg + ((size_t)(ck * 2 + (pos ? 0 : 1)) * 2) * LW + ch0;
            float* ns = p.new_state + ((size_t)(seq * 2 + jl) * 2 + (pos ? 0 : 1)) * LW + ch0;
#pragma unroll
            for (int e = 0; e < 8; ++e) ns[e] = a[e] * (pos ? cf[e] : cb[e]) + a[LW + e];
        }
        const size_t o0 = (size_t)(ck * 128 + rq * 32) * LW + ch0;
#pragma unroll
        for (int e = 0; e < 8; ++e) { cf[e] *= (1.0f / 255.0f); cb[e] *= (1.0f / 255.0f); }
        for (int t0 = 0; t0 < 32; t0 += 4) {
          u32x4 sq[4], gq[4]; u32x2 afq[4], abq[4];
#pragma unroll
          for (int tt = 0; tt < 4; ++tt) { const size_t o = o0 + (size_t)(t0 + tt) * LW; sq[tt] = *(const u32x4*)(p.S + o); gq[tt] = *(const u32x4*)(p.gate + o); afq[tt] = *(const u32x2*)(p.Af + o); abq[tt] = *(const u32x2*)(p.Ab + o); }
          asm volatile("" : "+v"(sq[0]), "+v"(sq[1]), "+v"(sq[2]), "+v"(sq[3]), "+v"(gq[0]), "+v"(gq[1]), "+v"(gq[2]), "+v"(gq[3]) :: "memory");
          asm volatile("" : "+v"(afq[0]), "+v"(afq[1]), "+v"(afq[2]), "+v"(afq[3]), "+v"(abq[0]), "+v"(abq[1]), "+v"(abq[2]), "+v"(abq[3]) :: "memory");
#pragma unroll
          for (int tt = 0; tt < 4; ++tt) { const size_t o = o0 + (size_t)(t0 + tt) * LW;
            const u32x4 s = sq[tt], gt = gq[tt]; const u32x2 af = afq[tt], ab = abq[tt];
            const unsigned sw[4] = {s.x, s.y, s.z, s.w}, gw[4] = {gt.x, gt.y, gt.z, gt.w};
            unsigned ow[4];
#pragma unroll
            for (int e2 = 0; e2 < 4; ++e2) {
                const unsigned fq = af[e2 >> 1] >> (16 * (e2 & 1)), bq = ab[e2 >> 1] >> (16 * (e2 & 1));
                const float lo = (__uint_as_float(sw[e2] << 16) + (float)(fq & 0xffu) * cf[2 * e2] + (float)(bq & 0xffu) * cb[2 * e2]) * __uint_as_float(gw[e2] << 16);
                const float hi = (__uint_as_float(sw[e2] & 0xffff0000u) + (float)((fq >> 8) & 0xffu) * cf[2 * e2 + 1] + (float)((bq >> 8) & 0xffu) * cb[2 * e2 + 1]) * __uint_as_float(gw[e2] & 0xffff0000u);
                ow[e2] = pk2(lo, hi); }
            *(uint4*)(p.zl + o) = make_uint4(ow[0], ow[1], ow[2], ow[3]); } }
    }
}
typedef short s16x4 __attribute__((ext_vector_type(4)));
__device__ __forceinline__ unsigned off_b(unsigned row, unsigned ch) { return 256u * row + 16u * (ch ^ (((row & 3) << 2) | ((row >> 2) & 3))); }
__device__ __forceinline__ unsigned tr_read_addr(unsigned lane, unsigned c, unsigned ks, unsigned t) {
    const unsigned h = lane >> 5, blk = (lane >> 4) & 1, q = (lane & 15) >> 2, pp = lane & 3;
    return off_b(16 * ks + 8 * h + 4 * t + q, 4 * c + 2 * blk + (pp >> 1)) + 8 * (pp & 1);
}
__device__ __forceinline__ void sgu_phase(const P& p, int jl, LAS unsigned char* lds, int wv) {
    const Ids I = fresh_ids(wv); const int tid = I.tid, lane = I.lane, wid = I.wid;
    LAS unsigned char* Aimg = lds; LAS unsigned char* Vimg = lds + 32768; LAS unsigned char* stage = lds;
    LAS float* rsb = (LAS float*)(lds + 98304); LAS float* bsl = rsb + 256;
    constexpr int NU = (NTOK / 128) * 8, SST = 528;
    u32x4 vreg[8], ureg[8]; float4 wlo[4], whi[4];
    int u = I.bid;
    if (u >= NU) return;
    const unsigned vo_v = (unsigned)((tid >> 5) * 8192 + (tid & 31) * 16), vo_z = (unsigned)((tid >> 5) * 4096 + (tid & 31) * 16), vo_w = (unsigned)(((tid >> 4) * 128 + (tid & 15) * 8) * 4);
#define SG_ISSUE(uu) do { const int n_ = (uu) >> 3, g_ = (uu) & 7; const char* vb_ = (const char*)(p.proj + (size_t)n_ * 128 * 4096 + 2048 + g_ * 256); const char* wb_ = (const char*)(p.sg_w_s + (size_t)(jl * 8 + g_) * 128 * 128); \
        _Pragma("unroll") for (int k = 0; k < 8; ++k) vreg[k] = *(const u32x4*)(vb_ + (size_t)k * 16 * 8192 + vo_v); \
        _Pragma("unroll") for (int k = 0; k < 4; ++k) { const char* wk_ = wb_ + (size_t)k * 32 * 512 + vo_w; wlo[k] = *(const float4*)wk_; whi[k] = *(const float4*)(wk_ + 16); } } while (0)
#define SG_RS(uu, bf) do { if (tid < 128) { const int n_ = (uu) >> 3, g_ = (uu) & 7; const float4* vp = (const float4*)(p.vss + (size_t)(n_ * 128 + tid) * 32); float sacc = 0.f; \
        _Pragma("unroll") for (int k = 0; k < 8; ++k) { const float4 v = vp[k]; sacc += (v.x + v.y) + (v.z + v.w); } \
        rsb[(bf) * 128 + tid] = rsqrtf(sacc * (1.0f / 2048.0f) + RMS_EPS); bsl[(bf) * 128 + tid] = p.sg_b_s[(jl * 8 + g_) * 128 + tid]; } } while (0)
    SG_ISSUE(u); SG_RS(u, 0);
    int buf = 0;
    for (; u < NU; u += I.G) {
        const int n = u >> 3, g = u & 7, row0 = n * 128;
        __syncthreads();
#pragma unroll
        for (int k = 0; k < 8; ++k) { const int it = tid + 512 * k, qq = it >> 5, cch = it & 31; *(LAS u32x4*)(Vimg + (cch >> 4) * 32768 + off_b(qq, cch & 15)) = vreg[k]; }
#pragma unroll
        for (int k = 0; k < 4; ++k) { const int it = tid + 512 * k, pp = it >> 4, chq = it & 15; const LAS float* r8 = rsb + buf * 128 + chq * 8;
            u32x4 pk; pk.x = pk2(wlo[k].x * r8[0], wlo[k].y * r8[1]); pk.y = pk2(wlo[k].z * r8[2], wlo[k].w * r8[3]); pk.z = pk2(whi[k].x * r8[4], whi[k].y * r8[5]); pk.w = pk2(whi[k].z * r8[6], whi[k].w * r8[7]);
            *(LAS u32x4*)(Aimg + off_b(pp, chq)) = pk; }
#pragma unroll
        for (int k = 0; k < 8; ++k) ureg[k] = *(const u32x4*)((const char*)(p.proj + (size_t)row0 * 4096 + g * 256) + (size_t)k * 16 * 8192 + vo_v);
        const int gcol = g * 256 + 32 * wid + (lane & 31); const float ng = p.sg_norm_g[jl * SGW + gcol];
        __syncthreads();
        f32x16 acc[4];
#pragma unroll
        for (int m = 0; m < 4; ++m)
#pragma unroll
            for (int r = 0; r < 16; ++r) acc[m][r] = 0.f;
        const LAS unsigned char* vb = Vimg + (wid >> 2) * 32768; const unsigned cblk = wid & 3;
#pragma unroll
        for (int s2 = 0; s2 < 8; ++s2) {
            const s16x4 b0 = __builtin_amdgcn_ds_read_tr16_b64_v4i16((LAS s16x4*)(vb + tr_read_addr(lane, cblk, s2, 0)));
            const s16x4 b1 = __builtin_amdgcn_ds_read_tr16_b64_v4i16((LAS s16x4*)(vb + tr_read_addr(lane, cblk, s2, 1)));
            bf16x8 B; B[0] = b0[0]; B[1] = b0[1]; B[2] = b0[2]; B[3] = b0[3]; B[4] = b1[0]; B[5] = b1[1]; B[6] = b1[2]; B[7] = b1[3];
#pragma unroll
            for (int m = 0; m < 4; ++m) { const bf16x8 A = *(const LAS bf16x8*)(Aimg + off_b(32 * m + (lane & 31), 2 * s2 + (lane >> 5))); acc[m] = __builtin_amdgcn_mfma_f32_32x32x16_bf16(A, B, acc[m], 0, 0, 0); }
        }
        __syncthreads();
        { LAS unsigned char* scol = stage + (32 * wid + (lane & 31)) * 2; const LAS float* bb = bsl + buf * 128;
#pragma unroll
          for (int m = 0; m < 4; ++m)
#pragma unroll
            for (int r = 0; r < 16; ++r) { const int pp = 32 * m + (r & 3) + 8 * (r >> 2) + 4 * (lane >> 5);
                *(LAS unsigned short*)(scol + pp * SST) = f2bf(acc[m][r] * ng + bb[pp]); } }
        const int un = u + I.G;
        if (un < NU) { SG_ISSUE(un); SG_RS(un, buf ^ 1); }
        __syncthreads();
#pragma unroll
        for (int k = 0; k < 8; ++k) { const int it = tid + 512 * k, pp = it >> 5, cch = it & 31;
            const u32x4 sv = *(const LAS u32x4*)(stage + pp * SST + cch * 16); const u32x4 uu = ureg[k]; u32x4 o;
            o.x = pk2(__uint_as_float(sv.x << 16) * __uint_as_float(uu.x << 16), __uint_as_float(sv.x & 0xffff0000u) * __uint_as_float(uu.x & 0xffff0000u));
            o.y = pk2(__uint_as_float(sv.y << 16) * __uint_as_float(uu.y << 16), __uint_as_float(sv.y & 0xffff0000u) * __uint_as_float(uu.y & 0xffff0000u));
            o.z = pk2(__uint_as_float(sv.z << 16) * __uint_as_float(uu.z << 16), __uint_as_float(sv.z & 0xffff0000u) * __uint_as_float(uu.z & 0xffff0000u));
            o.w = pk2(__uint_as_float(sv.w << 16) * __uint_as_float(uu.w << 16), __uint_as_float(sv.w & 0xffff0000u) * __uint_as_float(uu.w & 0xffff0000u));
            *(u32x4*)((char*)(p.zsg + (size_t)row0 * SGW + g * 256) + (size_t)k * 16 * 4096 + vo_z) = o; }
        buf ^= 1;
    }
#undef SG_ISSUE
#undef SG_RS
}


#define PIN8(a, b, c, d, e, f, g, h) asm volatile("" : "+v"(a), "+v"(b), "+v"(c), "+v"(d), "+v"(e), "+v"(f), "+v"(g), "+v"(h) :: "memory")
#define PIN4(a, b, c, d) asm volatile("" : "+v"(a), "+v"(b), "+v"(c), "+v"(d) :: "memory")

__device__ __forceinline__ void rowA_phase(const P& p, int l, int wv, bool dry = false) {
    const Ids I = fresh_ids(wv); const int lane = I.lane;
    constexpr int NPAIR = NTOK / 2;
    int pr = I.gw, s_cur = -1;
    float pfreq[4];
#pragma unroll
    for (int q = 0; q < 4; ++q) pfreq[q] = (l == 0) ? expf(-9.210340371976184f * (float)(4 * lane + q) / 256.0f) : 0.f;
    if (l > 0 && pr < NPAIR && lane < 32) s_cur = p.inv[(size_t)(lane & 15) * NTOK + 2 * pr + (lane >> 4)];
    for (; pr < NPAIR; pr += I.ngw) {
        const int r0 = 2 * pr, ci = tok_cond(r0), prn = pr + I.ngw;
        int s_nxt = -1;
        if (l > 0 && prn < NPAIR && lane < 32) s_nxt = p.inv[(size_t)(lane & 15) * NTOK + 2 * prn + (lane >> 4)];
        float4 xv[2][4];
        if (l == 0) {
#pragma unroll
            for (int rr = 0; rr < 2; ++rr) { const int r = r0 + rr;
                if (r < NCTX) {
#pragma unroll
                    for (int j = 0; j < 4; ++j) xv[rr][j] = *(const float4*)(p.x_prompt + (size_t)r * DM + 4 * lane + 256 * j);
                } else {
                    const int rs = r - NCTX, t = rs & 4095; const float frow = (float)(t >> 6), fcol = (float)(t & 63);
#pragma unroll
                    for (int j = 0; j < 4; ++j) {
                        float4 v = *(const float4*)(p.x_sample + (size_t)rs * DM + 4 * lane + 256 * j);
                        float e[4];
#pragma unroll
                        for (int q = 0; q < 4; ++q) { const float ang = (j < 2 ? frow : fcol) * pfreq[q]; e[q] = (j & 1) ? __cosf(ang) : __sinf(ang); }
                        v.x += e[0]; v.y += e[1]; v.z += e[2]; v.w += e[3]; xv[rr][j] = v;
                    }
                }
            }
        } else {
            u32x2 xr4[2][4];
#pragma unroll
            for (int rr = 0; rr < 2; ++rr)
#pragma unroll
                for (int j = 0; j < 4; ++j) xr4[rr][j] = *(const u32x2*)(p.x + (size_t)(r0 + rr) * DM + 4 * lane + 256 * j);
            const unsigned long long bal = __ballot(s_cur >= 0);
            unsigned buf[2][4][4]; unsigned nsel[2], rem[2];
#pragma unroll
            for (int rr = 0; rr < 2; ++rr) {
                unsigned m = (unsigned)__builtin_amdgcn_readfirstlane((int)((bal >> (16 * rr)) & 0xffffull)); nsel[rr] = (unsigned)__builtin_popcount(m);
#pragma unroll
                for (int k = 0; k < 4; ++k) if (m) { const int e = __builtin_ctz(m); m &= m - 1u; const int slot = __builtin_amdgcn_readlane(s_cur, 16 * rr + e);
                    const unsigned char* orow = p.outm + (size_t)slot * DM + 4 * lane;
#pragma unroll
                    for (int j = 0; j < 4; ++j) buf[rr][k][j] = *(const unsigned*)(orow + 256 * j); }
                rem[rr] = m;
            }
            PIN8(xr4[0][0], xr4[0][1], xr4[0][2], xr4[0][3], xr4[1][0], xr4[1][1], xr4[1][2], xr4[1][3]);
#pragma unroll
            for (int rr = 0; rr < 2; ++rr)
#pragma unroll
                for (int k = 0; k < 4; k += 2) PIN8(buf[rr][k][0], buf[rr][k][1], buf[rr][k][2], buf[rr][k][3], buf[rr][k + 1][0], buf[rr][k + 1][1], buf[rr][k + 1][2], buf[rr][k + 1][3]);
#pragma unroll
            for (int rr = 0; rr < 2; ++rr)
#pragma unroll
                for (int j = 0; j < 4; ++j) xv[rr][j] = xs_unpack(xr4[rr][j]);
            const float* g2 = p.mod + (size_t)((l - 1) * 9 + ci) * 6144 + 5 * 1024;
#pragma unroll
            for (int rr = 0; rr < 2; ++rr) {
                float4 acc[4];
#pragma unroll
                for (int j = 0; j < 4; ++j) acc[j] = make_float4(0.f, 0.f, 0.f, 0.f);
#pragma unroll
                for (int k = 0; k < 4; ++k) if (nsel[rr] > (unsigned)k) {
#pragma unroll
                    for (int j = 0; j < 4; ++j) { const f32x2 lo = __builtin_amdgcn_cvt_pk_f32_fp8((int)buf[rr][k][j], false), hi = __builtin_amdgcn_cvt_pk_f32_fp8((int)buf[rr][k][j], true); acc[j].x += lo[0]; acc[j].y += lo[1]; acc[j].z += hi[0]; acc[j].w += hi[1]; } }
                unsigned m = rem[rr];
                while (m) { const int e = __builtin_ctz(m); m &= m - 1u; const int slot = __builtin_amdgcn_readlane(s_cur, 16 * rr + e); const unsigned char* orow = p.outm + (size_t)slot * DM + 4 * lane;
#pragma unroll
                    for (int j = 0; j < 4; ++j) { const unsigned w = *(const unsigned*)(orow + 256 * j); const f32x2 lo = __builtin_amdgcn_cvt_pk_f32_fp8((int)w, false), hi = __builtin_amdgcn_cvt_pk_f32_fp8((int)w, true); acc[j].x += lo[0]; acc[j].y += lo[1]; acc[j].z += hi[0]; acc[j].w += hi[1]; } }
#pragma unroll
                for (int j = 0; j < 4; ++j) { const float4 g = *(const float4*)(g2 + 4 * lane + 256 * j);
                    xv[rr][j].x += 0.0625f * g.x * acc[j].x; xv[rr][j].y += 0.0625f * g.y * acc[j].y; xv[rr][j].z += 0.0625f * g.z * acc[j].z; xv[rr][j].w += 0.0625f * g.w * acc[j].w; }
            }
        }
        const float* md = p.mod + (size_t)((l < 4 ? l : 0) * 9 + ci) * 6144;
        float4 gsv[4], shv[4];
        { f32x4 pg[4], psc[4], psh[4];
#pragma unroll
          for (int j = 0; j < 4; ++j) { const int c0 = 4 * lane + 256 * j;
            if (l < 4) { pg[j] = *(const f32x4*)(p.norm1_g + l * 1024 + c0); psc[j] = *(const f32x4*)(md + 1024 + c0); psh[j] = *(const f32x4*)(md + c0); }
            else { pg[j] = *(const f32x4*)(p.final_norm_g + c0); psc[j] = (f32x4){0.f, 0.f, 0.f, 0.f}; psh[j] = (f32x4){0.f, 0.f, 0.f, 0.f}; } }
          PIN8(pg[0], pg[1], pg[2], pg[3], psc[0], psc[1], psc[2], psc[3]); PIN4(psh[0], psh[1], psh[2], psh[3]);
#pragma unroll
          for (int j = 0; j < 4; ++j) { shv[j] = make_float4(psh[j][0], psh[j][1], psh[j][2], psh[j][3]);
            gsv[j] = make_float4(pg[j][0] * (1.f + psc[j][0]), pg[j][1] * (1.f + psc[j][1]), pg[j][2] * (1.f + psc[j][2]), pg[j][3] * (1.f + psc[j][3])); } }
#pragma unroll
        for (int rr = 0; rr < 2; ++rr) {
            const int r = r0 + rr; bf16_t* xw = (dry ? p.gate : p.x) + (size_t)r * DM;
            float ss = 0.f;
#pragma unroll
            for (int j = 0; j < 4; ++j) { if (l < 4) { const u32x2 o = xs_pack(xv[rr][j]); *(u32x2*)(xw + 4 * lane + 256 * j) = o; xv[rr][j] = xs_unpack(o); }
                ss += xv[rr][j].x * xv[rr][j].x + xv[rr][j].y * xv[rr][j].y + xv[rr][j].z * xv[rr][j].z + xv[rr][j].w * xv[rr][j].w; }
            ss = wave_sum(ss, lane);
            const float rstd = rsqrtf(ss * (1.0f / 1024.0f) + RMS_EPS);
            if (l < 4) {
                if (l & 1) {
                float4 hv[4]; float amax = 0.f;
#pragma unroll
                for (int j = 0; j < 4; ++j) { const float4 gs = gsv[j], sh = shv[j];
                    hv[j] = make_float4(xv[rr][j].x * rstd * gs.x + sh.x, xv[rr][j].y * rstd * gs.y + sh.y, xv[rr][j].z * rstd * gs.z + sh.z, xv[rr][j].w * rstd * gs.w + sh.w);
                    amax = fmaxf(fmaxf(amax, fmaxf(fabsf(hv[j].x), fabsf(hv[j].y))), fmaxf(fabsf(hv[j].z), fabsf(hv[j].w))); }
#pragma unroll
                for (int o = 32; o >= 1; o >>= 1) amax = fmaxf(amax, shx(amax, o, lane));
                const float inv = amax > 0.f ? 127.0f / amax : 0.f;
                if (lane == 0) p.hsc[r] = amax * (1.0f / 127.0f);
                signed char* hr = p.hn8i + (size_t)r * DM;
#pragma unroll
                for (int j = 0; j < 4; ++j) *(unsigned*)(hr + 4 * lane + 256 * j) = pack4_i8(inv * hv[j].x, inv * hv[j].y, inv * hv[j].z, inv * hv[j].w);
                } else {
                bf16_t* hr = p.hn + (size_t)r * DM;
#pragma unroll
                for (int j = 0; j < 4; ++j) { const int c0 = 4 * lane + 256 * j; const float4 gs = gsv[j], sh = shv[j];
                    const float a = xv[rr][j].x * rstd * gs.x + sh.x, b = xv[rr][j].y * rstd * gs.y + sh.y, c = xv[rr][j].z * rstd * gs.z + sh.z, d = xv[rr][j].w * rstd * gs.w + sh.w;
                    uint2 w; w.x = (unsigned)f2bf(a) | ((unsigned)f2bf(b) << 16); w.y = (unsigned)f2bf(c) | ((unsigned)f2bf(d) << 16);
                    *(uint2*)(hr + c0) = w; }
                }
            } else {
#pragma unroll
                for (int j = 0; j < 4; ++j) { const int c0 = 4 * lane + 256 * j; const float4 g = gsv[j];
                    float4 o; o.x = xv[rr][j].x * rstd * g.x; o.y = xv[rr][j].y * rstd * g.y; o.z = xv[rr][j].z * rstd * g.z; o.w = xv[rr][j].w * rstd * g.w;
                    *(float4*)((dry ? (float*)p.gate : p.xout) + (size_t)r * DM + c0) = o; }
            }
        }
        s_cur = s_nxt;
    }
}

__device__ __forceinline__ void rowB_phase(const P& p, int l, LAS unsigned char* lds, int wv, bool dry = false) {
    const Ids I = fresh_ids(wv); const int tid = I.tid, lane = I.lane, gw = I.gw, ngw = I.ngw;
    LAS float* rT = (LAS float*)lds;
    { const float* rt = p.moe_router + (size_t)l * 1024 * 16;
      f32x4 rv[8];
#pragma unroll
      for (int q = 0; q < 8; ++q) rv[q] = *(const f32x4*)(rt + 4 * (tid + 512 * q));
#pragma unroll
      for (int q = 0; q < 8; ++q) { const int i = 4 * (tid + 512 * q), k = i >> 4, e = i & 15;
          f32x2 lo2; lo2[0] = rv[q][0]; lo2[1] = rv[q][1]; f32x2 hi2; hi2[0] = rv[q][2]; hi2[1] = rv[q][3];
          const int sl = (k & 1) * 2, pl0 = (((e >> 1) * 2 + ((k >> 1) & 1)) * 256 + (k >> 2)) * 4 + sl, pl1 = ((((e >> 1) + 1) * 2 + ((k >> 1) & 1)) * 256 + (k >> 2)) * 4 + sl;
          *(LAS f32x2*)(rT + pl0) = lo2; *(LAS f32x2*)(rT + pl1) = hi2; } }
    __syncthreads();
    for (int grp = gw; grp < NTOK / 4; grp += ngw) {
        const int r0 = grp * 4, ci = tok_cond(r0);
        const float* md = p.mod + (size_t)(l * 9 + ci) * 6144;
        float4 xv[4][4]; float rstd[4];
        {
            u32x2 xr4[4][4];
#pragma unroll
            for (int rr = 0; rr < 4; ++rr)
#pragma unroll
                for (int j = 0; j < 4; ++j) xr4[rr][j] = *(const u32x2*)(p.x + (size_t)(r0 + rr) * DM + 4 * lane + 256 * j);
#pragma unroll
            for (int rr = 0; rr < 4; rr += 2) { PIN8(xr4[rr][0], xr4[rr][1], xr4[rr][2], xr4[rr][3], xr4[rr + 1][0], xr4[rr + 1][1], xr4[rr + 1][2], xr4[rr + 1][3]); }
#pragma unroll
            for (int rr = 0; rr < 4; ++rr)
#pragma unroll
                for (int j = 0; j < 4; ++j) xv[rr][j] = xs_unpack(xr4[rr][j]);
        }
        float4 gsv[4], shv[4];
        { f32x4 pg[4], psc[4], psh[4];
#pragma unroll
          for (int j = 0; j < 4; ++j) { const int c0 = 4 * lane + 256 * j; pg[j] = *(const f32x4*)(p.norm2_g + l * 1024 + c0); psc[j] = *(const f32x4*)(md + 4096 + c0); psh[j] = *(const f32x4*)(md + 3072 + c0); }
          PIN8(pg[0], pg[1], pg[2], pg[3], psc[0], psc[1], psc[2], psc[3]); PIN4(psh[0], psh[1], psh[2], psh[3]);
#pragma unroll
          for (int j = 0; j < 4; ++j) { shv[j] = make_float4(psh[j][0], psh[j][1], psh[j][2], psh[j][3]);
            gsv[j] = make_float4(pg[j][0] * (1.f + psc[j][0]), pg[j][1] * (1.f + psc[j][1]), pg[j][2] * (1.f + psc[j][2]), pg[j][3] * (1.f + psc[j][3])); } }
#pragma unroll
        for (int rr = 0; rr < 4; ++rr) { float ss = 0.f;
#pragma unroll
            for (int j = 0; j < 4; ++j) { const float4 v = xv[rr][j]; ss += v.x * v.x + v.y * v.y + v.z * v.z + v.w * v.w; }
            rstd[rr] = rsqrtf(wave_sum(ss, lane) * (1.0f / 1024.0f) + RMS_EPS);
        }
        float lg[64];
#pragma unroll
        for (int i = 0; i < 64; ++i) lg[i] = 0.f;
#pragma unroll
        for (int j = 0; j < 4; ++j) { const int c0 = 4 * lane + 256 * j;
            const float4 gs = gsv[j], sh = shv[j];
            float4 h[4];
#pragma unroll
            for (int rr = 0; rr < 4; ++rr) { const float4 v = xv[rr][j]; const float rs = rstd[rr];
                h[rr] = make_float4(v.x * rs * gs.x + sh.x, v.y * rs * gs.y + sh.y, v.z * rs * gs.z + sh.z, v.w * rs * gs.w + sh.w);
                *(unsigned*)(p.hn8 + (size_t)(r0 + rr) * DM + c0) = pg8::pack4_fp8(h[rr].x, h[rr].y, h[rr].z, h[rr].w); }
            if (!(dry && PROBE_KIND == 12))
#pragma unroll
            for (int eg = 0; eg < 4; ++eg) {
                f32x4 wa[2], wb[2];
#pragma unroll
                for (int q = 0; q < 2; ++q) { const int ep = eg * 2 + q, kg = c0 >> 2; wa[q] = *(const LAS f32x4*)(rT + ((ep * 2 + 0) * 256 + kg) * 4); wb[q] = *(const LAS f32x4*)(rT + ((ep * 2 + 1) * 256 + kg) * 4); }
#pragma unroll
                for (int q = 0; q < 2; ++q)
#pragma unroll
                    for (int rr = 0; rr < 4; ++rr) { const int li = rr * 16 + (eg * 2 + q) * 2;
                        f32x2 acc; acc[0] = lg[li]; acc[1] = lg[li + 1];
                        f32x2 w0; w0[0] = wa[q][0]; w0[1] = wa[q][1]; f32x2 w1; w1[0] = wa[q][2]; w1[1] = wa[q][3]; f32x2 w2; w2[0] = wb[q][0]; w2[1] = wb[q][1]; f32x2 w3; w3[0] = wb[q][2]; w3[1] = wb[q][3];
                        f32x2 hx; hx[0] = h[rr].x; hx[1] = h[rr].x; f32x2 hy; hy[0] = h[rr].y; hy[1] = h[rr].y; f32x2 hz; hz[0] = h[rr].z; hz[1] = h[rr].z; f32x2 hw; hw[0] = h[rr].w; hw[1] = h[rr].w;
                        acc = __builtin_elementwise_fma(hx, w0, acc); acc = __builtin_elementwise_fma(hy, w1, acc); acc = __builtin_elementwise_fma(hz, w2, acc); acc = __builtin_elementwise_fma(hw, w3, acc);
                        lg[li] = acc[0]; lg[li + 1] = acc[1]; }
                __builtin_amdgcn_sched_barrier(0);
            }
        }
#pragma unroll
        for (int n = 32; n >= 1; n >>= 1) { const bool hi = (lane & n) != 0;
#pragma unroll
            for (int i = 0; i < n; ++i) { const float send = hi ? lg[i] : lg[i + n]; const float recv = shx(send, n, lane); lg[i] = (hi ? lg[i + n] : lg[i]) + recv; } }
        const float v = lg[0];
        float mx = v;
#pragma unroll
        for (int o = 8; o >= 1; o >>= 1) mx = fmaxf(mx, shx(mx, o, lane));
        const float ex = __expf(v - mx); float sm = ex;
#pragma unroll
        for (int o = 8; o >= 1; o >>= 1) sm += shx(sm, o, lane);
        p.affT[(size_t)(lane & 15) * NTOK + r0 + (lane >> 4)] = ex / sm;
        if (PROBE_KIND >= 16 && PROBE_KIND <= 17) p.affT2[(size_t)(lane & 15) * NTOK + r0 + (lane >> 4)] = ex / sm;
    }
}

__device__ __forceinline__ void mod_phase(const P& p, LAS unsigned char* lds, int wv) {
    const Ids I = fresh_ids(wv); const int bid = I.bid, tid = I.tid;
    { const int i = bid * 512 + tid; if (i < 4 * LW) { const float lam = p.lru_lam[i]; const float sp = (-lam > 20.f) ? -lam : log1pf(expf(-lam)); p.k2tab[i] = -8.0f * sp * 1.44269504089f; } }
    LAS float* sc = (LAS float*)lds; LAS float* red = sc + 1024 * 12;
    for (int i = tid; i < 9 * 1024; i += 512) { const int ci = i >> 10, k = i & 1023; const float v = ci == 0 ? p.c_ctx[k] : p.c[(ci - 1) * 1024 + k]; sc[k * 12 + ci] = v / (1.0f + __expf(-v)); }
    __syncthreads();
    for (int unit = bid; unit < 256; unit += I.G) {
        const int l = unit >> 6, n0 = (unit & 63) * 96, col = tid % 96, ks = tid / 96;
        if (ks < 5) {
            float acc[9];
#pragma unroll
            for (int ci = 0; ci < 9; ++ci) acc[ci] = 0.f;
            const int kb = ks * 208, nk = ks == 4 ? 192 : 208;
            const float* w = p.w_mod + ((size_t)l * 1024 + kb) * 6144 + n0 + col;
            const LAS float* scp = sc + kb * 12;
            for (int k0 = 0; k0 < nk; k0 += 16) {
                float wq[16];
#pragma unroll
                for (int u = 0; u < 16; ++u) wq[u] = w[(size_t)(k0 + u) * 6144];
#pragma unroll
                for (int u = 0; u < 16; ++u) { const LAS float* q = scp + (k0 + u) * 12; const f32x4 a = *(const LAS f32x4*)q, b = *(const LAS f32x4*)(q + 4); const float c8 = q[8];
                    acc[0] += a[0] * wq[u]; acc[1] += a[1] * wq[u]; acc[2] += a[2] * wq[u]; acc[3] += a[3] * wq[u];
                    acc[4] += b[0] * wq[u]; acc[5] += b[1] * wq[u]; acc[6] += b[2] * wq[u]; acc[7] += b[3] * wq[u]; acc[8] += c8 * wq[u]; }
            }
#pragma unroll
            for (int ci = 0; ci < 9; ++ci) red[(ks * 9 + ci) * 96 + col] = acc[ci];
        }
        __syncthreads();
        for (int o = tid; o < 9 * 96; o += 512) { const int ci = o / 96, cc = o - ci * 96;
            float sacc = 0.f;
#pragma unroll
            for (int q = 0; q < 5; ++q) sacc += red[(q * 9 + ci) * 96 + cc];
            p.mod[(size_t)(l * 9 + ci) * 6144 + n0 + cc] = sacc + p.b_mod[l * 6144 + n0 + cc]; }
        __syncthreads();
    }
}
__device__ __forceinline__ void cvt_seg(const float* W, bf16_t* WT, int K, int N, int nmat, LAS float* scr, int gw, int ngw, int lane) {
    const int nblk = N / 32, per = (K / 64) * nblk, total = per * nmat;
    int it = gw; if (it >= total) return;
    f32x4 cur[8], nxt[8];
    { const int mi = it / per; cv8_load(W + (size_t)mi * K * N, N, it - mi * per, nblk, lane, cur); }
    for (; it < total; it += ngw) {
        const int itn = (it + ngw < total) ? it + ngw : it;
        { const int mn = itn / per; cv8_load(W + (size_t)mn * K * N, N, itn - mn * per, nblk, lane, nxt); }
        asm volatile("" ::: "memory");
        const int mi = it / per;
        cvb_emit(cur, K, WT + (size_t)mi * K * N, scr, it - mi * per, nblk, lane);
#pragma unroll
        for (int i = 0; i < 8; ++i) cur[i] = nxt[i];
    }
}
__device__ __forceinline__ void cvt8_seg(const float* W, unsigned char* WT, int K, int N, LAS float* scr, int gw, int ngw, int lane, int lo, int total) {
    const int nblk = N / 32, per = (K / 64) * nblk;
    int it = lo + gw; if (it >= total) return;
    f32x4 cur[8], nxt[8];
    { const int mi = it / per; cv8_load(W + (size_t)mi * K * N, N, it - mi * per, nblk, lane, cur); }
    for (; it < total; it += ngw) {
        const int itn = (it + ngw < total) ? it + ngw : it;
        { const int mn = itn / per; cv8_load(W + (size_t)mn * K * N, N, itn - mn * per, nblk, lane, nxt); }
        asm volatile("" ::: "memory");
        const int mi = it / per;
        cv8_emit(cur, K, N, WT + (size_t)mi * K * N, scr, it - mi * per, nblk, lane);
#pragma unroll
        for (int i = 0; i < 8; ++i) cur[i] = nxt[i];
    }
}
__device__ __forceinline__ void cvt_moe_layer(const P& p, int l, LAS float* scr, int gw, int ngw, int lane, int ilo, int ihi) {
    unsigned char* dst = p.wt8 + (size_t)l * 3 * 16 * 1024 * 1024; const size_t lo = (size_t)l * 16 * 1024 * 1024;
    cvt8_seg(p.moe_w_gate + lo, dst, 1024, 1024, scr, gw, ngw, lane, ilo, ihi);
    cvt8_seg(p.moe_w_up + lo, dst + (size_t)16 * 1024 * 1024, 1024, 1024, scr, gw, ngw, lane, ilo, ihi);
    cvt8_seg(p.moe_w_down + lo, dst + (size_t)32 * 1024 * 1024, 1024, 1024, scr, gw, ngw, lane, ilo, ihi);
}
#define IDLE_CVT(nunits, ilo, ihi) do { const Ids Ic = fresh_ids(wv); const int rem_ = (nunits) % Ic.G; if (Ic.bid >= rem_) \
        cvt_moe_layer(p, l, (LAS float*)(lds + Ic.wid * 8704), (Ic.bid - rem_) * 8 + Ic.wid, (Ic.G - rem_) * 8, Ic.lane, (ilo), (ihi)); } while (0)

constexpr int LDS_TAB_OFF = 131072, LDS_MISC_OFF = 147456, LDS_BYTES = LDS_MISC_OFF + 1024;
constexpr int N_PHASES = 2 + 9 * 4;
constexpr int CV_I = 3072, CV_SC = 6144, CV_NX = 3072, CV_SO = 6144;
typedef const __attribute__((address_space(4))) P* KP;
__device__ __forceinline__ KP fresh(KP k) { asm volatile("" : "+s"(k)); return k; }
#if defined(__HIP_DEVICE_COMPILE__)
#define PL const P p = *fresh(kp)
#else
#define PL const P p = p_args
#endif
__global__ void __launch_bounds__(512, 2) k_fwd(P p_args, int ph_lo, int ph_hi) {
    const KP kp = (KP)__builtin_amdgcn_kernarg_segment_ptr(); (void)p_args;
    extern __shared__ __attribute__((aligned(16))) unsigned char lds_raw[];
    LAS unsigned char* lds = (LAS unsigned char*)lds_raw;
    const int tid = threadIdx.x; (void)ph_lo; (void)ph_hi;
    const int wv = __builtin_amdgcn_readfirstlane(tid >> 6);
    volatile LAS unsigned* MISC = (volatile LAS unsigned*)(lds + LDS_MISC_OFF);
    if (tid < 256) MISC[tid] = 0u;
    __syncthreads();
    { PL; const XcdBarrier b0 = xcd_barrier_post(p.bar, MISC + 8); if (tid == 0) MISC[10] = b0.x; }
#define GRID_SYNC() do { XcdBarrier b_; b_.bar = fresh(kp)->bar; b_.x = MISC[10]; b_.st = MISC + 8; xcd_barrier(b_); } while (0)
#if MK_PER_PHASE
#define IN(k) (ph_lo <= (k) && (k) < ph_hi)
#else
#define IN(k) true
#endif
#define SEAM(k) do { if (IN(k) && IN((k) + 1)) { GRID_SYNC(); if (PROBE_KIND == 11) GRID_SYNC(); } } while (0)
#define REPEAT(kind) for (int rep_ = 0; rep_ < ((PROBE_KIND == (kind)) ? 2 : 1); ++rep_)
#define REPBAR(kind) do { if (PROBE_KIND == (kind) && rep_ == 0) GRID_SYNC(); } while (0)

    if (IN(0)) REPEAT(10) {
        PL; mod_phase(p, lds, wv);
        const Ids I = fresh_ids(wv); const int gw = I.gw, ngw = I.ngw, lane = I.lane; LAS float* scr = (LAS float*)(lds + I.wid * 8704);
        cvt_seg(p.lru_w_in, p.wt_lru_in, 1024, 2560, 2, scr, gw, ngw, lane);
        cvt_seg(p.lru_w_out, p.wt_lru_out, 1280, 1024, 2, scr, gw, ngw, lane);
        cvt_seg(p.sg_w_out, p.wt_sg_out, 2048, 1024, 2, scr, gw, ngw, lane);
        cvt_seg(p.lru_w_a, p.wt_a, 128, 128, 40, scr, gw, ngw, lane);
        cvt_seg(p.lru_w_x, p.wt_x, 128, 128, 40, scr, gw, ngw, lane);
        __syncthreads();
        cvt_i8_panels(p.sg_w_in, p.wq_sg_in, p.wsc_sg_in, lds, I.bid, I.G, I.tid);
        REPBAR(10);
    }
    SEAM(0);
    if (IN(1)) REPEAT(7) { PL; rowA_phase(p, 0, wv, PROBE_KIND == 7 && rep_ == 0); REPBAR(7); }
    SEAM(1);
    for (int l = 0; l < 4; ++l) {
        const int jl = l >> 1, b = 2 + 9 * l;
        const size_t wmoe_off = (size_t)l * 3 * 16 * 1024 * 1024;
        if ((l & 1) == 0) {
            if (IN(b + 0)) REPEAT(1) { PL; const Ids I0 = fresh_ids(wv); pg8::Prob<pg8::K_LRU_IN, 1024> pr; pr.A = p.hn; pr.B0 = p.wt_lru_in + (size_t)jl * 2560 * 1024; pr.O0 = p.gate; pr.O1 = p.xpre; pr.S.init(NTOK, 2560, (int)gridDim.x, I0.bid); pr.tab = (LAS unsigned*)(lds + LDS_TAB_OFF); pg8::gemm_phase(lds, pr, wv); IDLE_CVT(1600, 0, CV_I); REPBAR(1); }
            SEAM(b + 0);
            if (IN(b + 1)) REPEAT(4) { PL; LruW W{p.wt_a, p.wt_x}; lru_scan_phase(p, W, jl, lds, wv); IDLE_CVT(NCK * 10, CV_I, CV_SC); REPBAR(4); }
            SEAM(b + 1);
            if (IN(b + 2)) REPEAT(5) { PL; lru_fix_phase(p, jl, wv); REPBAR(5); }
            SEAM(b + 2);
            if (IN(b + 3)) REPEAT(1) { PL; const Ids I0 = fresh_ids(wv); pg8::Prob<pg8::K_OUT, 1280> pr; pr.A = p.zl; pr.B0 = p.wt_lru_out + (size_t)jl * 1024 * 1280; pr.O0 = p.x; pr.gvec = p.mod + (size_t)l * 9 * 6144; pr.S.init(NTOK, 1024, (int)gridDim.x, I0.bid); pr.tab = (LAS unsigned*)(lds + LDS_TAB_OFF); pg8::gemm_phase(lds, pr, wv); IDLE_CVT(640, CV_SC, 8192); REPBAR(1); }
            SEAM(b + 3);
        } else {
            if (IN(b + 0)) REPEAT(1) { PL; const Ids I0 = fresh_ids(wv); pg8::Prob<pg8::K_SG_IN, 1024> pr; pr.A = p.hn8i; pr.B0 = p.wq_sg_in + (size_t)jl * 4096 * 1024; pr.O0 = p.proj; pr.vss = p.vss; pr.gsel = p.hsc; pr.gvec = p.wsc_sg_in + (size_t)jl * 4096; pr.S.init(NTOK, 4096, (int)gridDim.x, I0.bid); pr.tab = (LAS unsigned*)(lds + LDS_TAB_OFF); pg8::gemm_phase(lds, pr, wv); REPBAR(1); }
            SEAM(b + 0);
            if (IN(b + 1)) REPEAT(6) { PL; sgu_phase(p, jl, lds, wv); REPBAR(6); }
            SEAM(b + 1);
#if MK_PER_PHASE
            SEAM(b + 2);
#endif
            if (IN(b + 3)) REPEAT(1) { PL; const Ids I0 = fresh_ids(wv); pg8::Prob<pg8::K_OUT, 2048> pr; pr.A = p.zsg; pr.B0 = p.wt_sg_out + (size_t)jl * 1024 * 2048; pr.O0 = p.x; pr.gvec = p.mod + (size_t)l * 9 * 6144; pr.S.init(NTOK, 1024, (int)gridDim.x, I0.bid); pr.tab = (LAS unsigned*)(lds + LDS_TAB_OFF); pg8::gemm_phase(lds, pr, wv); IDLE_CVT(640, CV_NX, CV_SO); REPBAR(1); }
            SEAM(b + 3);
        }
        if (IN(b + 4)) for (int rep_ = 0; rep_ < ((PROBE_KIND == 8 || PROBE_KIND == 12) ? 2 : 1); ++rep_) { PL; rowB_phase(p, l, lds, wv, (PROBE_KIND == 8 || PROBE_KIND == 12) && rep_ == 0); if ((PROBE_KIND == 8 || PROBE_KIND == 12) && rep_ == 0) GRID_SYNC(); }
        SEAM(b + 4);
        if (IN(b + 5)) for (int rep_ = 0; rep_ < ((PROBE_KIND == 9 || (PROBE_KIND >= 16 && PROBE_KIND <= 17)) ? 2 : 1); ++rep_) {
            PL; const Ids I = fresh_ids(wv); const int bid = I.bid;
            if (bid < 32) { LAS unsigned (*red)[8] = (LAS unsigned (*)[8])lds; const int e = bid & 15;
                const bool xp = (PROBE_KIND >= 16 && PROBE_KIND <= 17 && rep_ == 0); const float* asrc = xp ? p.affT2 : p.affT;
                if (bid < 16) select_body<16>(p, asrc, e, 0, CAP_CTX, 0, red, wv, xp); else select_body<64>(p, asrc, e, NCTX, CAP_SMP, CAP_CTX, red, wv, xp); }
            else if (!(PROBE_KIND >= 16 && PROBE_KIND <= 17 && rep_ == 0)) { if (l & 1) cvt_moe_layer(p, l, (LAS float*)(lds + I.wid * 8704), (bid - 32) * 8 + I.wid, (I.G - 32) * 8, I.lane, CV_SO, 8192); else cvt_moe_layer(p, l + 1, (LAS float*)(lds + I.wid * 8704), (bid - 32) * 8 + I.wid, (I.G - 32) * 8, I.lane, 0, CV_NX); }
            if ((PROBE_KIND == 9 || (PROBE_KIND >= 16 && PROBE_KIND <= 17)) && rep_ == 0) GRID_SYNC();
        }
        SEAM(b + 5);
        if (IN(b + 6)) REPEAT(2) { PL; const Ids I0 = fresh_ids(wv); pg8::Prob<pg8::K_MOE1, 1024> pr; pr.A = p.hn8; pr.B0 = p.wt8 + wmoe_off; pr.B1 = p.wt8 + wmoe_off + (size_t)16 * 1024 * 1024; pr.O0 = p.hh8; pr.idx = p.idx; pr.S.init(NSLOT, 2048, (int)gridDim.x, I0.bid); pr.tab = (LAS unsigned*)(lds + LDS_TAB_OFF); pg8::gemm_phase(lds, pr, wv); REPBAR(2); }
        SEAM(b + 6);
        if (IN(b + 7)) REPEAT(2) { PL; const Ids I0 = fresh_ids(wv); pg8::Prob<pg8::K_MOE2, 1024> pr; pr.A = p.hh8; pr.B0 = p.wt8 + wmoe_off + (size_t)32 * 1024 * 1024; pr.O0 = p.outm; pr.gsel = p.gsel; pr.S.init(NSLOT, 1024, (int)gridDim.x, I0.bid); pr.tab = (LAS unsigned*)(lds + LDS_TAB_OFF); pg8::gemm_phase(lds, pr, wv); REPBAR(2); }
        SEAM(b + 7);
        if (IN(b + 8)) REPEAT(7) { PL; rowA_phase(p, l + 1, wv, PROBE_KIND == 7 && rep_ == 0); REPBAR(7); }
        SEAM(b + 8);
    }
#undef IN
#undef SEAM
}

static inline size_t al(size_t x) { return (x + 255) & ~(size_t)255; }
extern "C" void kernel_launch(void* const* d_in, const int* in_sizes, int n_in, void* d_out, int out_size, void* d_ws, size_t ws_size, hipStream_t stream) {
    P p{};
    const float* const* in = (const float* const*)d_in;
    p.x_prompt = in[0]; p.x_sample = in[1]; p.state_lru = in[2]; p.c = in[3]; p.c_ctx = in[4]; p.norm1_g = in[5]; p.norm2_g = in[6]; p.w_mod = in[7]; p.b_mod = in[8];
    p.lru_w_in = in[9]; p.lru_conv_w = in[10]; p.lru_conv_b = in[11]; p.lru_w_a = in[12]; p.lru_b_a = in[13]; p.lru_w_x = in[14]; p.lru_b_x = in[15]; p.lru_lam = in[16]; p.lru_w_out = in[17];
    p.sg_w_in = in[18]; p.sg_norm_g = in[19]; p.sg_w_s = in[20]; p.sg_b_s = in[21]; p.sg_w_out = in[22];
    p.moe_router = in[23]; p.moe_w_gate = in[24]; p.moe_w_up = in[25]; p.moe_w_down = in[26]; p.final_norm_g = in[27];
    p.xout = (float*)d_out; p.new_state = (float*)d_out + (size_t)NTOK * DM;
    char* w = (char*)d_ws; size_t o = 0;
    auto take = [&](size_t bytes) { char* r = w + o; o += al(bytes); return r; };
    p.bar = (unsigned*)take((size_t)XCD_BAR_WORDS * 4);
    p.mod = (float*)take((size_t)4 * 9 * 6144 * 4);
    p.x = (bf16_t*)take((size_t)NTOK * DM * 2);
    p.hn = (bf16_t*)take((size_t)NTOK * DM * 2);
    const size_t R = (size_t)NTOK * LW * 2;
    char* r1 = take(R); char* r2 = take(R); char* r3 = take(R); char* r4 = take(R); char* r5 = take(R);
    char* r6 = take((size_t)NTOK * SGW * 2 - R);
    (void)r6;
    p.gate = (bf16_t*)r1; p.xpre = (bf16_t*)r2; p.zl = (bf16_t*)r2; p.S = (bf16_t*)r3; p.Af = (unsigned char*)r4; p.Ab = (unsigned char*)r5;
    p.proj = (bf16_t*)r1; p.zsg = (bf16_t*)r5; p.hh8 = (unsigned char*)r1; p.hn8 = (unsigned char*)p.hn; p.hn8i = (signed char*)p.hn; p.outm = (unsigned char*)r3; p.y = (bf16_t*)r3;
    p.agg = (float*)take((size_t)NCK128 * 2 * 2 * LW * 4);
    p.k2tab = (float*)take((size_t)4 * LW * 4);
    p.vss = (float*)take((size_t)NTOK * 32 * 4);
    p.affT = (float*)take((size_t)NE * NTOK * 4);
    p.affT2 = (float*)take((size_t)NE * NTOK * 4);
    p.idx = (int*)take((size_t)NSLOT * 4);
    p.gsel = (float*)take((size_t)NSLOT * 4);
    p.inv = (int*)take((size_t)NE * NTOK * 4);
    p.wt_lru_in = (bf16_t*)take((size_t)2 * 2560 * 1024 * 2); p.wq_lru_in = nullptr; p.wsc_lru_in = nullptr;
    p.wt_lru_out = (bf16_t*)take((size_t)2 * 1024 * 1280 * 2);
    p.wq_sg_in = (signed char*)take((size_t)2 * 4096 * 1024); p.wsc_sg_in = (float*)take((size_t)2 * 4096 * 4); p.wpm_sg_in = (float*)take((size_t)16 * 2 * 4096 * 4);
    p.hsc = (float*)take((size_t)NTOK * 4);
    p.wt_sg_out = (bf16_t*)take((size_t)2 * 1024 * 2048 * 2);
    p.wt_a = (bf16_t*)take((size_t)40 * 128 * 128 * 2);
    p.wt_x = (bf16_t*)take((size_t)40 * 128 * 128 * 2);
    p.wt8 = (unsigned char*)take((size_t)4 * 3 * 16 * 1024 * 1024);
    (void)ws_size; (void)in_sizes; (void)n_in; (void)out_size;

    static int grid = 0;
    if (!grid) {
        int dev = 0, cus = 0;
        (void)hipGetDevice(&dev); (void)hipDeviceGetAttribute(&cus, hipDeviceAttributeMultiprocessorCount, dev);
        (void)hipFuncSetAttribute((const void*)k_fwd, hipFuncAttributeMaxDynamicSharedMemorySize, LDS_BYTES);
        grid = cus > 0 ? cus : 256;
    }
    (void)hipMemsetAsync(p.bar, 0, (size_t)XCD_BAR_WORDS * 4, stream);
#if MK_PER_PHASE
    for (int ph = 0; ph < N_PHASES; ++ph) hipLaunchKernelGGL(k_fwd, dim3(grid), dim3(512), LDS_BYTES, stream, p, ph, ph + 1);
#else
    hipLaunchKernelGGL(k_fwd, dim3(grid), dim3(512), LDS_BYTES, stream, p, 0, N_PHASES);
#endif
}
```

```cpp
#include <hip/hip_runtime.h>
#include <stdint.h>

#ifndef PROBE_KIND
#define PROBE_KIND 0
#endif
#ifndef MK_PER_PHASE
#define MK_PER_PHASE 0
#endif

typedef unsigned short bf16_t;
constexpr int DM = 1024, NCTX = 8192, NSMP = 32768, NTOK = 40960;
constexpr int LW = 1280, SGW = 2048, NE = 16;
constexpr int CAP_CTX = 1024, CAP_SMP = 4096, SLOTS_E = 5120, NSLOT = NE * SLOTS_E;
constexpr int NCK = NTOK / 256;
constexpr float RMS_EPS = 1e-6f;
#define LAS __attribute__((address_space(3)))

__device__ __forceinline__ float bf2f(bf16_t b) { return __uint_as_float(((unsigned)b) << 16); }
__device__ __forceinline__ bf16_t f2bf(float f) { unsigned r; asm("v_cvt_pk_bf16_f32 %0, %1, %1" : "=v"(r) : "v"(f)); return (bf16_t)r; }
__device__ __forceinline__ int tok_cond(int r) { return r < NCTX ? 0 : 1 + ((r - NCTX) >> 12); }
__device__ __forceinline__ float shx(float v, int o, int lane) { return __int_as_float(__builtin_amdgcn_ds_bpermute((lane ^ o) << 2, __float_as_int(v))); }
__device__ __forceinline__ unsigned shxu(unsigned v, int o, int lane) { return (unsigned)__builtin_amdgcn_ds_bpermute((lane ^ o) << 2, (int)v); }
__device__ __forceinline__ unsigned shupu(unsigned v, int o, int lane) { return (unsigned)__builtin_amdgcn_ds_bpermute(((lane - o) & 63) << 2, (int)v); }
__device__ __forceinline__ float wave_sum(float v, int lane) {
#pragma unroll
    for (int o = 32; o >= 1; o >>= 1) v += shx(v, o, lane);
    return v;
}


struct Ids { int tid, lane, wid, bid, G, gw, ngw; };
__device__ __forceinline__ Ids fresh_ids(int wv) {
    Ids d; unsigned ones = ~0u; asm volatile("" : "+s"(ones)); int ln = (int)__builtin_amdgcn_mbcnt_hi(ones, __builtin_amdgcn_mbcnt_lo(ones, 0u)); asm volatile("" : "+v"(ln)); int w = wv; asm volatile("" : "+s"(w)); int b = blockIdx.x; asm volatile("" : "+s"(b));
    d.tid = w * 64 + ln; d.lane = ln; d.wid = w; d.bid = b; d.G = gridDim.x; d.gw = b * 8 + w; d.ngw = d.G * 8; return d;
}

struct P {
    const float *x_prompt, *x_sample, *state_lru, *c, *c_ctx, *norm1_g, *norm2_g, *w_mod, *b_mod;
    const float *lru_w_in, *lru_conv_w, *lru_conv_b, *lru_w_a, *lru_b_a, *lru_w_x, *lru_b_x, *lru_lam, *lru_w_out;
    const float *sg_w_in, *sg_norm_g, *sg_w_s, *sg_b_s, *sg_w_out;
    const float *moe_router, *moe_w_gate, *moe_w_up, *moe_w_down, *final_norm_g;
    bf16_t* x;
    float* xout;
    float* new_state;
    unsigned* bar;
    float* mod;
    bf16_t *hn, *y;
    bf16_t *gate, *xpre, *S, *zl;
    unsigned char *Af, *Ab;
    float* agg;
    float* k2tab;
    bf16_t *proj;
    bf16_t *zsg;
    float* vss;
    float* affT;
    float* affT2;
    int* idx;
    float* gsel;
    int* inv;
    unsigned char* hh8;
    unsigned char* hn8;
    unsigned char* outm;
    bf16_t *wt_lru_in, *wt_lru_out, *wt_sg_out, *wt_a, *wt_x;
    signed char *wq_lru_in, *wq_sg_in;
    float *wsc_lru_in, *wsc_sg_in;
    float* wpm_sg_in;
    signed char* hn8i;
    float* hsc;
    unsigned char* wt8;
};


#define XB_TMO      128
#define XB_XCNT(j)  (256  + 64 * (j))
#define XB_XSUB(j)  (1280 + 64 * (j))
#define XB_XGEN(j)  (2304 + 64 * (j))
#define XB_TOP      3328
#define XB_TOPGEN   3392
#define XCD_BAR_WORDS 3456
#define XB_SPIN_CAP (1u << 18)
__device__ __forceinline__ unsigned xb_ld(unsigned* p)              { return __hip_atomic_load(p, __ATOMIC_RELAXED, __HIP_MEMORY_SCOPE_AGENT); }
__device__ __forceinline__ unsigned xb_add(unsigned* p, unsigned v) { return __hip_atomic_fetch_add(p, v, __ATOMIC_RELAXED, __HIP_MEMORY_SCOPE_AGENT); }
__device__ __forceinline__ unsigned xb_xcc_id() { return (unsigned)__builtin_amdgcn_s_getreg((3 << 11) | 20) & 0xFu; }
#define XB_SPIN(cond, bar) do { unsigned _sp = 0; while (cond) { __builtin_amdgcn_s_sleep(1); \
    if ((++_sp & 255u) == 0u) { if (xb_ld(&(bar)[XB_TMO])) break; if (_sp > XB_SPIN_CAP) { atomicAdd(&(bar)[XB_TMO], 1u); break; } } } } while (0)
struct XcdBarrier { unsigned* bar; unsigned x; volatile LAS unsigned* st; };
__device__ __forceinline__ XcdBarrier xcd_barrier_post(unsigned* bar, volatile LAS unsigned* st) {
    XcdBarrier b; b.bar = bar; b.x = xb_xcc_id(); b.st = st;
    if (threadIdx.x == 0) (void)xb_add(&bar[XB_XCNT(b.x)], 1u);
    return b;
}
__device__ __forceinline__ void xcd_barrier_complete(unsigned* bar, unsigned x, unsigned& nloc, unsigned& nx) {
    const unsigned G = gridDim.x * gridDim.y * gridDim.z;
    unsigned sum, cnt, mine, sp = 0u;
    for (;;) {
        sum = 0u; cnt = 0u; mine = 0u;
#pragma unroll
        for (unsigned j = 0; j < 16; ++j) { const unsigned c = xb_ld(&bar[XB_XCNT(j)]); sum += c; cnt += (c > 0u) ? 1u : 0u; mine = (j == x) ? c : mine; }
        if (sum == G) break;
        __builtin_amdgcn_s_sleep(1);
        if ((++sp & 255u) == 0u) { if (xb_ld(&bar[XB_TMO])) break; if (sp > XB_SPIN_CAP) { atomicAdd(&bar[XB_TMO], 1u); break; } }
    }
    nloc = mine > 0u ? mine : 1u; nx = cnt > 0u ? cnt : 1u;
}
__device__ __forceinline__ void xcd_barrier(const XcdBarrier& b) {
    asm volatile("s_waitcnt vmcnt(0)" ::: "memory");
    __syncthreads();
    if (threadIdx.x == 0) {
        unsigned* bar = b.bar;
        __builtin_amdgcn_s_waitcnt(0);
        unsigned nloc = b.st[0], nx = b.st[1];
        if (nloc == 0u) { xcd_barrier_complete(bar, b.x, nloc, nx); b.st[0] = nloc; b.st[1] = nx; }
        const unsigned old = xb_add(&bar[XB_XSUB(b.x)], 1u);
        const unsigned gen = old / nloc;
        if (old + 1u == (gen + 1u) * nloc) {
            __builtin_amdgcn_fence(__ATOMIC_RELEASE, "agent");
            asm volatile("s_waitcnt vmcnt(0)" ::: "memory");
            const unsigned og = xb_add(&bar[XB_TOP], 1u);
            const unsigned tg = og / nx;
            if (og + 1u == (tg + 1u) * nx) xb_add(&bar[XB_TOPGEN], 1u);
            else XB_SPIN(xb_ld(&bar[XB_TOPGEN]) == tg, bar);
            __builtin_amdgcn_fence(__ATOMIC_ACQUIRE, "agent");
            xb_add(&bar[XB_XGEN(b.x)], 1u);
            asm volatile("s_waitcnt vmcnt(0)" ::: "memory");
        } else {
            XB_SPIN(xb_ld(&bar[XB_XGEN(b.x)]) == gen, bar);
            __builtin_amdgcn_fence(__ATOMIC_ACQUIRE, "agent");
            asm volatile("s_waitcnt vmcnt(0)" ::: "memory");
        }
    }
    __syncthreads();
}

__device__ __forceinline__ void transpose32(unsigned (&A)[32]) {
#pragma unroll
    for (int s = 0; s < 5; ++s) {
        const int j = 16 >> s;
        const unsigned m = (s == 0) ? 0x0000ffffu : (s == 1) ? 0x00ff00ffu : (s == 2) ? 0x0f0f0f0fu : (s == 3) ? 0x33333333u : 0x55555555u;
#pragma unroll
        for (int blk = 0; blk < 32; blk += 2 * j)
#pragma unroll
            for (int i = 0; i < j; ++i) { const int k = blk + i; const unsigned t = ((A[k] >> j) ^ A[k + j]) & m; A[k] ^= t << j; A[k + j] ^= t; }
    }
}
__device__ __forceinline__ unsigned wave_total_u32(unsigned v) {
    v += (unsigned)__builtin_amdgcn_update_dpp(0, (int)v, 0x111, 0xf, 0xf, false);
    v += (unsigned)__builtin_amdgcn_update_dpp(0, (int)v, 0x112, 0xf, 0xf, false);
    v += (unsigned)__builtin_amdgcn_update_dpp(0, (int)v, 0x114, 0xf, 0xf, false);
    v += (unsigned)__builtin_amdgcn_update_dpp(0, (int)v, 0x118, 0xf, 0xf, false);
    return (unsigned)(__builtin_amdgcn_readlane((int)v, 15) + __builtin_amdgcn_readlane((int)v, 31)) + (unsigned)(__builtin_amdgcn_readlane((int)v, 47) + __builtin_amdgcn_readlane((int)v, 63));
}
template <int CNT> __device__ __forceinline__ void select_body(const P& p, const float* affsrc, int e, int base_tok, int cap, int slot_base, LAS unsigned (*red)[8], int wv, int early = 0) {
    const Ids I = fresh_ids(wv); const int tid = I.tid, lane = I.lane, wid = I.wid;
    const float* col = affsrc + (size_t)e * NTOK + base_tok + tid * CNT;
    unsigned key[CNT];
#pragma unroll
    for (int k = 0; k < CNT; k += 4) { const float4 v = *(const float4*)(col + k); key[k] = __float_as_uint(v.x); key[k + 1] = __float_as_uint(v.y); key[k + 2] = __float_as_uint(v.z); key[k + 3] = __float_as_uint(v.w); }
    constexpr int NBLK = (CNT + 31) / 32;
    unsigned pl[NBLK][32], alive[NBLK];
#pragma unroll
    for (int b = 0; b < NBLK; ++b) {
#pragma unroll
        for (int r = 0; r < 32; ++r) pl[b][r] = (b * 32 + r < CNT) ? key[(b * 32 + r < CNT) ? b * 32 + r : 0] : 0u;
        transpose32(pl[b]);
        alive[b] = (CNT - 32 * b >= 32) ? 0xffffffffu : ((1u << ((CNT - 32 * b) & 31)) - 1u);
    }
    unsigned T = 0u, above = 0u, cg = 0u; int pp = 0;
#pragma unroll
    for (int bit = 30; bit >= 0; --bit) {
        unsigned m[NBLK], c = 0u;
#pragma unroll
        for (int b = 0; b < NBLK; ++b) { m[b] = alive[b] & pl[b][bit]; c += (unsigned)__builtin_popcount(m[b]); }
        const unsigned wsum = wave_total_u32(c);
        if (lane == 0) red[pp][wid] = wsum;
        __syncthreads();
        unsigned part = 0;
#pragma unroll
        for (int w = 0; w < 8; ++w) part += red[pp][w];
        const bool take = above + part >= (unsigned)cap;
        if (take) T |= 1u << bit; else { above += part; cg += c; }
#pragma unroll
        for (int b = 0; b < NBLK; ++b) alive[b] = take ? m[b] : (alive[b] ^ m[b]);
        pp ^= 1;
    }
    if (PROBE_KIND == 17 && early) { if (tid == 0) p.affT2[(size_t)e * NTOK + base_tok] = __uint_as_float(T); return; }
    unsigned ceq = 0u;
#pragma unroll
    for (int b = 0; b < NBLK; ++b) ceq += (unsigned)__builtin_popcount(alive[b]);
    unsigned pg = cg, pe = ceq;
#pragma unroll
    for (int o = 1; o < 64; o <<= 1) { const unsigned a = shupu(pg, o, lane), b = shupu(pe, o, lane); if (lane >= o) { pg += a; pe += b; } }
    __syncthreads();
    if (lane == 63) { red[0][wid] = pg; red[1][wid] = pe; }
    __syncthreads();
    unsigned offg = 0, offe = 0, totg = 0;
#pragma unroll
    for (int w = 0; w < 8; ++w) { if (w < wid) { offg += red[0][w]; offe += red[1][w]; } totg += red[0][w]; }
    const unsigned need = (unsigned)cap - totg;
    unsigned eg = offg + pg - cg;
    unsigned ee = offe + pe - ceq;
    constexpr int N = CNT * 512, ISTR = CNT + 2;
    LAS short* invS = (LAS short*)((LAS unsigned char*)red + 256);
    LAS int* idxS = (LAS int*)((LAS unsigned char*)invS + 512 * ISTR * 2);
    LAS unsigned* gS = (LAS unsigned*)(idxS + CNT * 64);
#pragma unroll
    for (int k = 0; k < CNT; ++k) {
        const bool gt = key[k] > T, eq = key[k] == T;
        const bool sel = gt || (eq && ee < need);
        int pos = -1;
        if (sel) { pos = (int)(eg + (ee < need ? ee : need)); idxS[pos] = base_tok + tid * CNT + k; gS[pos] = key[k]; }
        eg += gt ? 1u : 0u; ee += eq ? 1u : 0u;
        invS[tid * ISTR + k] = (short)pos;
    }
    __syncthreads();
    const int sbase = e * SLOTS_E + slot_base;
    int* invg = p.inv + (size_t)e * NTOK + base_tok;
    for (int i = tid; i < N; i += 512) { const int t = i / CNT, k = i - t * CNT; const int v = invS[t * ISTR + k]; invg[i] = v < 0 ? -1 : sbase + v; }
    for (int i = tid; i < CNT * 64; i += 512) { p.idx[sbase + i] = idxS[i]; p.gsel[sbase + i] = __uint_as_float(gS[i]); }
}

typedef short bf16x8 __attribute__((ext_vector_type(8)));
typedef float f32x4 __attribute__((ext_vector_type(4)));
typedef float f32x2 __attribute__((ext_vector_type(2)));
typedef unsigned u32x4 __attribute__((ext_vector_type(4)));
typedef unsigned u32x2 __attribute__((ext_vector_type(2)));
__device__ __forceinline__ float h2f(unsigned h) { return (float)__builtin_bit_cast(_Float16, (unsigned short)h); }
__device__ __forceinline__ unsigned f2h(float f) { return (unsigned)__builtin_bit_cast(unsigned short, (_Float16)f); }
__device__ __forceinline__ float4 xs_unpack(u32x2 w) { return make_float4(h2f(w[0] & 0xffffu), h2f(w[0] >> 16), h2f(w[1] & 0xffffu), h2f(w[1] >> 16)); }
__device__ __forceinline__ u32x2 xs_pack(float4 v) { u32x2 o; o[0] = f2h(v.x) | (f2h(v.y) << 16); o[1] = f2h(v.z) | (f2h(v.w) << 16); return o; }

namespace pg8 {
constexpr int BM = 256, BK = 64, HALF = 128, HTB = HALF * BK * 2, STAGE_BYTES = 8 * HTB, NXCD = 8, WGM = 8;
__host__ __device__ __forceinline__ int lds_byte(int r, int c) { const int st = (r >> 4) * 2 + (c >> 5), rr = r & 15, cc = c & 31, ob = rr * 64 + cc * 2; return st * 1024 + (ob ^ (((ob >> 9) & 1) << 5)); }
__host__ __device__ __forceinline__ void stage_rc(int b, int& R, int& C) { const int st = b / 1024, sb = b % 1024, swz = sb ^ (((sb >> 9) & 1) << 5); R = (st >> 1) * 16 + swz / 64; C = (st & 1) * 32 + (swz % 64) / 2; }
__host__ __device__ __forceinline__ int perm32(int rho) { const int n = rho >> 4, i = rho & 15; return 8 * (i >> 2) + 4 * n + (i & 3); }
struct Unit { int pm, pn; };
struct StaticOrder {
    int nM, nN, nwg, G, c;
    __host__ __device__ void init(int M, int N, int G_, int c_) { nM = M / BM; nN = N / BM; nwg = nM * nN; G = G_; c = c_; }
    __host__ __device__ bool next(int i, Unit& u) const {
        const long L = (long)i * G + c; if (L >= nwg) return false;
        int wgid = (int)L; { const int q = nwg / NXCD, r = nwg % NXCD, xcd = wgid % NXCD, off = wgid / NXCD; wgid = (xcd < r ? xcd * (q + 1) : r * (q + 1) + (xcd - r) * q) + off; }
        const int nig = WGM * nN, gid = wgid / nig, fm = gid * WGM, gsz = (nM % WGM == 0) ? WGM : ((nM - fm) < WGM ? (nM - fm) : WGM);
        u.pm = fm + ((wgid % nig) % gsz); u.pn = (wgid % nig) / gsz; return true;
    }
};
__device__ __forceinline__ unsigned cvt_pk_bf16(float lo, float hi) { unsigned r; asm volatile("v_cvt_pk_bf16_f32 %0, %1, %2" : "=v"(r) : "v"(lo), "v"(hi)); return r; }
__device__ __forceinline__ float fast_sigmoid(float x) { return __builtin_amdgcn_rcpf(1.0f + __builtin_amdgcn_exp2f(-1.44269504089f * x)); }
__device__ __forceinline__ f32x4 gelu_fast4(f32x4 x) {
    const float c0 = -1.44269504089f * 1.5957691216057308f, c1 = c0 * 0.044715f;
    f32x2 a; a[0] = x[0]; a[1] = x[1]; f32x2 b; b[0] = x[2]; b[1] = x[3];
    f32x2 ta = __builtin_elementwise_fma(a * a, (f32x2){c1, c1}, (f32x2){c0, c0}) * a, tb = __builtin_elementwise_fma(b * b, (f32x2){c1, c1}, (f32x2){c0, c0}) * b;
    f32x2 da, db; da[0] = __builtin_amdgcn_exp2f(ta[0]); da[1] = __builtin_amdgcn_exp2f(ta[1]); db[0] = __builtin_amdgcn_exp2f(tb[0]); db[1] = __builtin_amdgcn_exp2f(tb[1]);
    da = da + 1.0f; db = db + 1.0f;
    f32x2 ra, rb; ra[0] = __builtin_amdgcn_rcpf(da[0]); ra[1] = __builtin_amdgcn_rcpf(da[1]); rb[0] = __builtin_amdgcn_rcpf(db[0]); rb[1] = __builtin_amdgcn_rcpf(db[1]);
    ra = ra * a; rb = rb * b;
    f32x4 o; o[0] = ra[0]; o[1] = ra[1]; o[2] = rb[0]; o[3] = rb[1]; return o;
}
__device__ __forceinline__ f32x4 silu_mul4(f32x4 g, f32x4 u) {
    f32x2 a; a[0] = g[0]; a[1] = g[1]; f32x2 b; b[0] = g[2]; b[1] = g[3]; f32x2 ua; ua[0] = u[0]; ua[1] = u[1]; f32x2 ub; ub[0] = u[2]; ub[1] = u[3];
    const f32x2 za = a * -1.44269504089f, zb = b * -1.44269504089f;
    f32x2 da, db; da[0] = __builtin_amdgcn_exp2f(za[0]); da[1] = __builtin_amdgcn_exp2f(za[1]); db[0] = __builtin_amdgcn_exp2f(zb[0]); db[1] = __builtin_amdgcn_exp2f(zb[1]);
    da = da + 1.0f; db = db + 1.0f;
    f32x2 ra, rb; ra[0] = __builtin_amdgcn_rcpf(da[0]); ra[1] = __builtin_amdgcn_rcpf(da[1]); rb[0] = __builtin_amdgcn_rcpf(db[0]); rb[1] = __builtin_amdgcn_rcpf(db[1]);
    ra = (a * ra) * ua; rb = (b * rb) * ub;
    f32x4 o; o[0] = ra[0]; o[1] = ra[1]; o[2] = rb[0]; o[3] = rb[1]; return o;
}
__device__ __forceinline__ float gelu_fast(float x) { const float u2 = 1.5957691216057308f * (x + 0.044715f * x * x * x); return x * fast_sigmoid(u2); }

enum Kind { K_LRU_IN = 0, K_SG_IN = 1, K_OUT = 2, K_MOE1 = 3, K_MOE2 = 4 };
typedef int i32x8 __attribute__((ext_vector_type(8)));
typedef int i32x4 __attribute__((ext_vector_type(4)));
__device__ __forceinline__ unsigned pack4_fp8(float a, float b, float c, float d) { int v = 0; v = __builtin_amdgcn_cvt_pk_fp8_f32(a, b, v, false); v = __builtin_amdgcn_cvt_pk_fp8_f32(c, d, v, true); return (unsigned)v; }
template <int KIND, int KK> struct Prob {
    static constexpr int K = KK;
    static constexpr bool FP8 = (KIND == K_MOE1 || KIND == K_MOE2);
    static constexpr bool I8 = (KIND == K_SG_IN);
    static constexpr int ROWB = (FP8 || I8) ? KK : 2 * KK;
    static constexpr bool GATHER = (KIND == K_MOE1);
    const void* A; const void* B0; const void* B1;
    void* O0; bf16_t* O1; float* vss; const int* idx; const float* gsel; const float* gvec;
    StaticOrder S;
    LAS unsigned* tab;
    __device__ __forceinline__ bool next(int i, Unit& u) const { return S.next(i, u); }
    __device__ __forceinline__ void prep(int tid) const {
        if constexpr (KIND == K_MOE1 || KIND == K_MOE2 || I8) {
            const int r = tid & 255, par = tid >> 8;
            for (int i0 = 0; ; i0 += 16) {
                unsigned v[8]; bool ok[8];
#pragma unroll
                for (int j = 0; j < 8; ++j) { Unit u; ok[j] = S.next(i0 + 2 * j + par, u); const int src = ok[j] ? u.pm * 256 + r : 0;
                    if constexpr (KIND == K_MOE1) v[j] = (unsigned)idx[src] * (unsigned)ROWB; else v[j] = __float_as_uint(gsel[src]); }
#pragma unroll
                for (int j = 0; j < 8; ++j) if (ok[j]) tab[(i0 + 2 * j + par) * 256 + r] = v[j];
                Unit u2; if (!S.next(i0 + 16, u2)) break;
            }
            __syncthreads();
        }
    }
    __device__ __forceinline__ void a_off(const Unit& u, int ui, const int (&R)[2], const int (&C)[2], unsigned (&off)[2][2]) const {
#pragma unroll
        for (int h = 0; h < 2; ++h)
#pragma unroll
            for (int i = 0; i < 2; ++i) {
                if constexpr (KIND == K_MOE1) off[h][i] = tab[ui * 256 + h * 128 + R[i]] + (unsigned)(C[i] * 2);
                else off[h][i] = (unsigned)(u.pm * 256 + h * 128 + R[i]) * (unsigned)ROWB + (unsigned)(C[i] * 2);
            }
    }
    __device__ __forceinline__ const char* b_half(const Unit& u, int h) const {
        if constexpr (KIND == K_MOE1) { const int e = u.pm / 20; return (const char*)(h ? B1 : B0) + ((size_t)e * 1024 + (size_t)u.pn * 128) * ROWB; }
        else if constexpr (KIND == K_MOE2) { const int e = u.pm / 20; return (const char*)B0 + ((size_t)e * 1024 + (size_t)u.pn * 256 + h * 128) * ROWB; }
        else return (const char*)B0 + ((size_t)u.pn * 256 + h * 128) * ROWB;
    }
    __device__ __forceinline__ void epi(const f32x4 (&acc)[2][2][4][2], const Unit& u, int ui, int wr, int wc, int fr, int fq) const {
        const int rloc0 = wr * 64 + fr, lane = fq * 16 + fr;
        const int cl = wc * 32 + 8 * fq;
        if constexpr (KIND == K_OUT) {
            const int ci = tok_cond(u.pm * 256);
            const float* g1p = gvec + (size_t)ci * 6144 + 2048 + u.pn * 256 + cl;
            f32x4 g[2][2];
#pragma unroll
            for (int bj = 0; bj < 2; ++bj) { g[bj][0] = *(const f32x4*)(g1p + bj * 128); g[bj][1] = *(const f32x4*)(g1p + bj * 128 + 4); }
            bf16_t* xb = (bf16_t*)O0 + (size_t)(u.pm * 256 + rloc0) * 1024 + u.pn * 256 + cl;
#pragma unroll
            for (int ai = 0; ai < 2; ++ai) {
                u32x4 xq[4][2];
#pragma unroll
                for (int m = 0; m < 4; ++m)
#pragma unroll
                    for (int bj = 0; bj < 2; ++bj) xq[m][bj] = *(const u32x4*)(xb + (size_t)(ai * 128 + m * 16) * 1024 + bj * 128);
                asm volatile("" : "+v"(xq[0][0]), "+v"(xq[0][1]), "+v"(xq[1][0]), "+v"(xq[1][1]), "+v"(xq[2][0]), "+v"(xq[2][1]), "+v"(xq[3][0]), "+v"(xq[3][1]) :: "memory");
#pragma unroll
                for (int m = 0; m < 4; ++m)
#pragma unroll
                    for (int bj = 0; bj < 2; ++bj) { const u32x4 w = xq[m][bj]; const f32x4 a0 = acc[ai][bj][m][0], a1 = acc[ai][bj][m][1]; u32x4 o;
                        o.x = f2h(h2f(w.x & 0xffffu) + g[bj][0][0] * a0[0]) | (f2h(h2f(w.x >> 16) + g[bj][0][1] * a0[1]) << 16);
                        o.y = f2h(h2f(w.y & 0xffffu) + g[bj][0][2] * a0[2]) | (f2h(h2f(w.y >> 16) + g[bj][0][3] * a0[3]) << 16);
                        o.z = f2h(h2f(w.z & 0xffffu) + g[bj][1][0] * a1[0]) | (f2h(h2f(w.z >> 16) + g[bj][1][1] * a1[1]) << 16);
                        o.w = f2h(h2f(w.w & 0xffffu) + g[bj][1][2] * a1[2]) | (f2h(h2f(w.w >> 16) + g[bj][1][3] * a1[3]) << 16);
                        *(u32x4*)(xb + (size_t)(ai * 128 + m * 16) * 1024 + bj * 128) = o; }
            }
        } else if constexpr (KIND == K_MOE1) {
#pragma unroll
            for (int ai = 0; ai < 2; ++ai)
#pragma unroll
                for (int m = 0; m < 4; ++m) {
                    const int row = u.pm * 256 + rloc0 + ai * 128 + m * 16;
                    const f32x4 g0 = acc[ai][0][m][0], g1 = acc[ai][0][m][1], u0 = acc[ai][1][m][0], u1 = acc[ai][1][m][1];
                    float o[8];
#pragma unroll
                    for (int j = 0; j < 1; ++j) { const f32x4 s0 = silu_mul4(g0, u0), s1 = silu_mul4(g1, u1); o[0] = s0[0]; o[1] = s0[1]; o[2] = s0[2]; o[3] = s0[3]; o[4] = s1[0]; o[5] = s1[1]; o[6] = s1[2]; o[7] = s1[3]; }
                    u32x2 w; w.x = pack4_fp8(o[0], o[1], o[2], o[3]); w.y = pack4_fp8(o[4], o[5], o[6], o[7]);
                    *(u32x2*)((unsigned char*)O0 + (size_t)row * 1024 + u.pn * 128 + cl) = w;
                }
        } else {
            f32x4 csc[2][2];
            if constexpr (I8) {
#pragma unroll
                for (int bj = 0; bj < 2; ++bj) { const float* wp = gvec + u.pn * 256 + bj * 128 + cl; csc[bj][0] = *(const f32x4*)wp; csc[bj][1] = *(const f32x4*)(wp + 4); }
            }
#pragma unroll
            for (int ai = 0; ai < 2; ++ai)
#pragma unroll
                for (int m = 0; m < 4; ++m) {
                    const int rl = rloc0 + ai * 128 + m * 16, row = u.pm * 256 + rl;
                    float gs = 1.0f; if constexpr (KIND == K_MOE2 || I8) gs = __uint_as_float(tab[ui * 256 + rl]);
                    float ssq = 0.f;
#pragma unroll
                    for (int bj = 0; bj < 2; ++bj) {
                        f32x4 v0 = acc[ai][bj][m][0], v1 = acc[ai][bj][m][1];
                        if constexpr (I8) {
                            const f32x4 s0 = csc[bj][0], s1 = csc[bj][1];
#pragma unroll
                            for (int j = 0; j < 4; ++j) { v0[j] = (float)__float_as_int(v0[j]) * (gs * s0[j]); v1[j] = (float)__float_as_int(v1[j]) * (gs * s1[j]); }
                        }
                        bf16_t* dst;
                        if constexpr (KIND == K_LRU_IN) {
                            if (u.pn < 5) {
#pragma unroll
                                for (int j = 0; j < 1; ++j) { v0 = gelu_fast4(v0); v1 = gelu_fast4(v1); }
                                dst = (bf16_t*)O0 + (size_t)row * 1280 + u.pn * 256 + bj * 128 + cl;
                            } else dst = O1 + (size_t)row * 1280 + (u.pn - 5) * 256 + bj * 128 + cl;
                        } else if constexpr (KIND == K_SG_IN) {
#pragma unroll
                            for (int j = 0; j < 1; ++j) { v0 = gelu_fast4(v0); v1 = gelu_fast4(v1); const f32x4 sq = v0 * v0 + v1 * v1; ssq += (sq[0] + sq[1]) + (sq[2] + sq[3]); }
                            dst = (bf16_t*)O0 + (size_t)row * 4096 + u.pn * 256 + bj * 128 + cl;
                        } else if constexpr (KIND == K_MOE2) {
                            v0 = v0 * (gs * 16.0f); v1 = v1 * (gs * 16.0f);
                            u32x2 w8; w8.x = pack4_fp8(v0[0], v0[1], v0[2], v0[3]); w8.y = pack4_fp8(v1[0], v1[1], v1[2], v1[3]);
                            *(u32x2*)((unsigned char*)O0 + (size_t)row * 1024 + u.pn * 256 + bj * 128 + cl) = w8;
                            continue;
                        } else dst = (bf16_t*)O0 + (size_t)row * 1024 + u.pn * 256 + bj * 128 + cl;
                        u32x4 w; w.x = cvt_pk_bf16(v0[0], v0[1]); w.y = cvt_pk_bf16(v0[2], v0[3]); w.z = cvt_pk_bf16(v1[0], v1[1]); w.w = cvt_pk_bf16(v1[2], v1[3]);
                        *(u32x4*)dst = w;
                    }
                    if constexpr (KIND == K_SG_IN) {
                        if (u.pn >= 8) { ssq += shx(ssq, 16, lane); ssq += shx(ssq, 32, lane); if (fq == 0) vss[(size_t)row * 32 + (u.pn - 8) * 4 + wc] = ssq; }
                    }
                }
        }
    }
};

template <class Pr>
__device__ __forceinline__ void gemm_phase(LAS unsigned char* lds, const Pr& pr, int wv) {
    constexpr int ROWB = Pr::ROWB, nt = ROWB / (BK * 2); constexpr bool FP8 = Pr::FP8;
    const Ids I = fresh_ids(wv); const int tid = I.tid, wid = I.wid, lane = I.lane, wr = wid >> 2, wc = wid & 3, fr = lane & 15, fq = lane >> 4;
    int R[2], C[2]; unsigned voffB[2];
#pragma unroll
    for (int i = 0; i < 2; ++i) { stage_rc(tid * 16 + i * 8192, R[i], C[i]); const int Rb = (R[i] & ~31) + perm32(R[i] & 31); voffB[i] = (unsigned)Rb * (unsigned)ROWB + (unsigned)(C[i] * 2); }
    const unsigned ldsw = (unsigned)wid * 1024u;
    const int aoff = lds_byte(wr * 64 + fr, fq * 8), boff = lds_byte(wc * 32 + fr, fq * 8);
#define PG8_SA(b, h) (((b) * 2 + (h)) * HTB)
#define PG8_SB(b, h) ((4 + (b) * 2 + (h)) * HTB)
#define PG8_STAGE(bufoff, gbase, voff) do { LAS unsigned char* lb_ = lds + ldsw; asm volatile("" : "+s"(lb_));     \
        _Pragma("unroll") for (int _i = 0; _i < 2; ++_i) \
        __builtin_amdgcn_global_load_lds((const unsigned*)((const char*)(gbase) + (voff)[_i]), (LAS unsigned*)(lb_ + (bufoff) + _i * 8192), 16, 0, 0); } while (0)
#define PG8_LD8(off_) ({ const i32x4 lo_ = *(const LAS i32x4*)(lds + (off_)); const i32x4 hi_ = *(const LAS i32x4*)(lds + (off_) + 1024); __builtin_shufflevector(lo_, hi_, 0, 1, 2, 3, 4, 5, 6, 7); })
#define PG8_LDA8(dst, b, h) do { _Pragma("unroll") for (int m = 0; m < 4; ++m) dst[m] = PG8_LD8(PG8_SA(b, h) + aoff + m * 2048); } while (0)
#define PG8_LDB8(dst, b, h) do { _Pragma("unroll") for (int n = 0; n < 2; ++n) dst[n] = PG8_LD8(PG8_SB(b, h) + boff + n * 2048); } while (0)
#define PG8_MMA8(ai, bj, At, Bt) do { __builtin_amdgcn_s_setprio(1); _Pragma("unroll") for (int m = 0; m < 4; ++m) _Pragma("unroll") for (int n = 0; n < 2; ++n) \
        asm volatile("v_mfma_scale_f32_16x16x128_f8f6f4 %0, %1, %2, %0, %3, %4 op_sel_hi:[0,0,0]" : "+v"(acc[ai][bj][m][n]) : "v"(Bt[n]), "v"(At[m]), "v"(sclW), "v"(sclX)); __builtin_amdgcn_s_setprio(0); } while (0)
#define PG8_LDA(dst, b, h) do { _Pragma("unroll") for (int m = 0; m < 4; ++m) _Pragma("unroll") for (int k = 0; k < 2; ++k) dst[m][k] = *(const LAS bf16x8*)(lds + PG8_SA(b, h) + aoff + m * 2048 + k * 1024); } while (0)
#define PG8_LDB(dst, b, h) do { _Pragma("unroll") for (int n = 0; n < 2; ++n) _Pragma("unroll") for (int k = 0; k < 2; ++k) dst[n][k] = *(const LAS bf16x8*)(lds + PG8_SB(b, h) + boff + n * 2048 + k * 1024); } while (0)
#define PG8_MMA(ai, bj, At, Bt) do { __builtin_amdgcn_s_setprio(1); _Pragma("unroll") for (int m = 0; m < 4; ++m) _Pragma("unroll") for (int n = 0; n < 2; ++n) _Pragma("unroll") for (int k = 0; k < 2; ++k) \
        acc[ai][bj][m][n] = __builtin_amdgcn_mfma_f32_16x16x32_bf16(Bt[n][k], At[m][k], acc[ai][bj][m][n], 0, 0, 0); __builtin_amdgcn_s_setprio(0); } while (0)
#define PG8_WAIT_V(n) asm volatile("s_waitcnt vmcnt(" #n ")" ::: "memory")
#define PG8_WAIT_L(n) asm volatile("s_waitcnt lgkmcnt(" #n ")" ::: "memory")
#define PG8_BAR __builtin_amdgcn_s_barrier()
#define PG8_SCHED __builtin_amdgcn_sched_barrier(0)
    pr.prep(tid);
    Unit cur, nxt; int ui = 0;
    if (!pr.next(0, cur)) return;
    f32x4 acc[2][2][4][2];
#pragma unroll
    for (int a = 0; a < 2; ++a)
#pragma unroll
        for (int b = 0; b < 2; ++b)
#pragma unroll
            for (int m = 0; m < 4; ++m)
#pragma unroll
                for (int n = 0; n < 2; ++n) acc[a][b][m][n] = (f32x4){0.f, 0.f, 0.f, 0.f};
    bf16x8 At[4][2], B0[2][2], B1[2][2]; i32x8 At8[4], B08[2], B18[2];
    const int sclW = 0x7a7a7a7a, sclX = 0x7f7f7f7f;
#define PG8_XLDA(b, h) do { if constexpr (FP8) PG8_LDA8(At8, b, h); else PG8_LDA(At, b, h); } while (0)
#define PG8_XLDB0(b, h) do { if constexpr (FP8) PG8_LDB8(B08, b, h); else PG8_LDB(B0, b, h); } while (0)
#define PG8_XLDB1(b, h) do { if constexpr (FP8) PG8_LDB8(B18, b, h); else PG8_LDB(B1, b, h); } while (0)
#define PG8_MMAI(ai, bj, At, Bt) do { __builtin_amdgcn_s_setprio(1); _Pragma("unroll") for (int m = 0; m < 4; ++m) _Pragma("unroll") for (int n = 0; n < 2; ++n) _Pragma("unroll") for (int k = 0; k < 2; ++k) \
        asm volatile("v_mfma_i32_16x16x64_i8 %0, %1, %2, %0" : "+v"(acc[ai][bj][m][n]) : "v"(Bt[n][k]), "v"(At[m][k])); __builtin_amdgcn_s_setprio(0); } while (0)
#define PG8_XMMA0(ai, bj) do { if constexpr (FP8) PG8_MMA8(ai, bj, At8, B08); else if constexpr (Pr::I8) PG8_MMAI(ai, bj, At, B0); else PG8_MMA(ai, bj, At, B0); } while (0)
#define PG8_XMMA1(ai, bj) do { if constexpr (FP8) PG8_MMA8(ai, bj, At8, B18); else if constexpr (Pr::I8) PG8_MMAI(ai, bj, At, B1); else PG8_MMA(ai, bj, At, B1); } while (0)
    const char* const Ab = (const char*)pr.A;
    unsigned cA[2][2], nA[2][2];
    pr.a_off(cur, 0, R, C, cA);
    const char* cB0 = pr.b_half(cur, 0); const char* cB1 = pr.b_half(cur, 1);
    constexpr unsigned kstep = BK * 2;
    PG8_STAGE(PG8_SB(0, 0), cB0, voffB); PG8_STAGE(PG8_SB(0, 1), cB1, voffB); PG8_STAGE(PG8_SA(0, 0), Ab, cA[0]); PG8_STAGE(PG8_SA(0, 1), Ab, cA[1]);
    if (wr == 1) PG8_BAR;
    PG8_WAIT_V(2); PG8_BAR;
    PG8_STAGE(PG8_SB(1, 0), cB0 + kstep, voffB); PG8_STAGE(PG8_SA(1, 0), Ab + kstep, cA[0]); PG8_STAGE(PG8_SB(1, 1), cB1 + kstep, voffB);
    PG8_WAIT_V(6); PG8_BAR;
    for (;;) {
        const bool has_next = pr.next(ui + 1, nxt);
        const char* nB0 = cB0; const char* nB1 = cB1;
        unsigned dA = 0u;
        if (has_next) { nB0 = pr.b_half(nxt, 0); nB1 = pr.b_half(nxt, 1);
            if constexpr (Pr::GATHER) pr.a_off(nxt, ui + 1, R, C, nA); else dA = (unsigned)((nxt.pm - cur.pm) * 256) * (unsigned)ROWB; }
        else if constexpr (Pr::GATHER) {
#pragma unroll
            for (int h = 0; h < 2; ++h)
#pragma unroll
                for (int i = 0; i < 2; ++i) nA[h][i] = cA[h][i];
        }
#pragma unroll 1
        for (int t = 0; t < nt; t += 2) {
            const bool last = (t == nt - 2);
            const unsigned k1 = (unsigned)(t + 1) * kstep, k2 = last ? 0u : (unsigned)(t + 2) * kstep, k3 = k2 + kstep;
            unsigned s2[2][2];
#pragma unroll
            for (int h = 0; h < 2; ++h)
#pragma unroll
                for (int i = 0; i < 2; ++i) { if constexpr (Pr::GATHER) s2[h][i] = last ? nA[h][i] : cA[h][i]; else s2[h][i] = cA[h][i] + (last ? dA : 0u); }
            const char* b20 = (last ? nB0 : cB0) + k2; const char* b21 = (last ? nB1 : cB1) + k2;
            PG8_XLDB0(0, 0); PG8_XLDB1(0, 1); PG8_SCHED; PG8_XLDA(0, 0); PG8_STAGE(PG8_SA(1, 1), Ab + k1, cA[1]);
            PG8_WAIT_V(8); PG8_WAIT_L(0); PG8_BAR; PG8_XMMA0(0, 0); PG8_XMMA1(0, 1); PG8_BAR; PG8_SCHED;
            PG8_XLDA(0, 1); PG8_STAGE(PG8_SB(0, 0), b20, voffB); PG8_STAGE(PG8_SB(0, 1), b21, voffB); PG8_STAGE(PG8_SA(0, 0), Ab + k2, s2[0]);
            PG8_WAIT_V(8); PG8_WAIT_L(0); PG8_BAR; PG8_XMMA0(1, 0); PG8_XMMA1(1, 1); PG8_BAR; PG8_SCHED;
            PG8_XLDB0(1, 0); PG8_XLDB1(1, 1); PG8_SCHED; PG8_XLDA(1, 0); PG8_STAGE(PG8_SA(0, 1), Ab + k2, s2[1]);
            PG8_WAIT_V(8); PG8_WAIT_L(0); PG8_BAR; PG8_XMMA0(0, 0); PG8_XMMA1(0, 1); PG8_BAR; PG8_SCHED;
            PG8_XLDA(1, 1); PG8_STAGE(PG8_SB(1, 0), b20 + kstep, voffB); PG8_STAGE(PG8_SB(1, 1), b21 + kstep, voffB); PG8_STAGE(PG8_SA(1, 0), Ab + k3, s2[0]);
            PG8_WAIT_V(8); PG8_WAIT_L(0); PG8_BAR; PG8_XMMA0(1, 0); PG8_XMMA1(1, 1); PG8_BAR; PG8_SCHED;
        }
        if (wr == 0) PG8_BAR;
        pr.epi(acc, cur, ui, wr, wc, fr, fq);
        if (!has_next) break;
#pragma unroll
        for (int a = 0; a < 2; ++a)
#pragma unroll
            for (int b = 0; b < 2; ++b)
#pragma unroll
                for (int m = 0; m < 4; ++m)
#pragma unroll
                    for (int n = 0; n < 2; ++n) acc[a][b][m][n] = (f32x4){0.f, 0.f, 0.f, 0.f};
        cur = nxt; cB0 = nB0; cB1 = nB1; ++ui;
#pragma unroll
        for (int h = 0; h < 2; ++h)
#pragma unroll
            for (int i = 0; i < 2; ++i) { if constexpr (Pr::GATHER) cA[h][i] = nA[h][i]; else cA[h][i] += dA; }
        if (wr == 1) PG8_BAR;
    }
    PG8_WAIT_V(0);
    PG8_BAR;
#undef PG8_SA
#undef PG8_SB
#undef PG8_STAGE
#undef PG8_LDA
#undef PG8_LD8
#undef PG8_LDA8
#undef PG8_LDB8
#undef PG8_MMA8
#undef PG8_XLDA
#undef PG8_XLDB0
#undef PG8_XLDB1
#undef PG8_XMMA0
#undef PG8_MMAI
#undef PG8_XMMA1
#undef PG8_LDB
#undef PG8_MMA
#undef PG8_WAIT_V
#undef PG8_WAIT_L
#undef PG8_BAR
#undef PG8_SCHED
}
}


__device__ __forceinline__ unsigned pk2(float lo, float hi) { unsigned r; asm("v_cvt_pk_bf16_f32 %0, %1, %2" : "=v"(r) : "v"(lo), "v"(hi)); return r; }
__device__ __forceinline__ void transpose_item(const float* W, int K, int N, bf16_t* WT, LAS float* scr, int item, int lane) {
    const int nblk = N / 32, kb = item / nblk, nb = item % nblk, k0 = 64 * kb, n0 = 32 * nb;
#pragma unroll 8
    for (int i = 0; i < 32; ++i) { const int kk = 2 * i + (lane >> 5); scr[kk * 33 + (lane & 31)] = W[(size_t)(k0 + kk) * N + n0 + (lane & 31)]; }
    asm volatile("s_waitcnt lgkmcnt(0)" ::: "memory");
    const int c = lane & 7;
#pragma unroll
    for (int j = 0; j < 4; ++j) { const int n = (lane >> 3) + 8 * j; const LAS float* s = scr + (8 * c) * 33 + n;
        u32x4 o; o.x = pk2(s[0 * 33], s[1 * 33]); o.y = pk2(s[2 * 33], s[3 * 33]); o.z = pk2(s[4 * 33], s[5 * 33]); o.w = pk2(s[6 * 33], s[7 * 33]);
        *(u32x4*)(WT + (size_t)(n0 + n) * K + k0 + 8 * c) = o; }
    asm volatile("s_waitcnt lgkmcnt(0)" ::: "memory");
}

__device__ __forceinline__ void cv8_load(const float* W, int N, int item, int nblk, int lane, f32x4 (&v)[8]) {
    const int kb = item / nblk, nb = item - kb * nblk; const float* src = W + (size_t)(64 * kb + (lane >> 3)) * N + 32 * nb + (lane & 7) * 4;
#pragma unroll
    for (int i = 0; i < 8; ++i) v[i] = *(const f32x4*)(src + (size_t)(8 * i) * N);
}
__device__ __forceinline__ void cv8_emit(const f32x4 (&v)[8], int K, int N, unsigned char* WT, LAS float* scr, int item, int nblk, int lane) {
    const int kb = item / nblk, nb = item - kb * nblk, k0 = 64 * kb, n0 = 32 * nb;
    { LAS float* d = scr + (lane >> 3) * 33 + (lane & 7) * 4;
#pragma unroll
      for (int i = 0; i < 8; ++i) { d[(8 * i) * 33 + 0] = v[i][0]; d[(8 * i) * 33 + 1] = v[i][1]; d[(8 * i) * 33 + 2] = v[i][2]; d[(8 * i) * 33 + 3] = v[i][3]; } }
    asm volatile("s_waitcnt lgkmcnt(0)" ::: "memory");
    const int c = lane & 3;
#pragma unroll
    for (int jj = 0; jj < 2; ++jj) { const int n = (lane >> 2) + 16 * jj; const LAS float* sp = scr + (16 * c) * 33 + n;
        u32x4 o;
        o.x = pg8::pack4_fp8(32.f * sp[0 * 33], 32.f * sp[1 * 33], 32.f * sp[2 * 33], 32.f * sp[3 * 33]);     o.y = pg8::pack4_fp8(32.f * sp[4 * 33], 32.f * sp[5 * 33], 32.f * sp[6 * 33], 32.f * sp[7 * 33]);
        o.z = pg8::pack4_fp8(32.f * sp[8 * 33], 32.f * sp[9 * 33], 32.f * sp[10 * 33], 32.f * sp[11 * 33]);   o.w = pg8::pack4_fp8(32.f * sp[12 * 33], 32.f * sp[13 * 33], 32.f * sp[14 * 33], 32.f * sp[15 * 33]);
        *(u32x4*)(WT + (size_t)(n0 + n) * K + k0 + 16 * c) = o; }
    asm volatile("s_waitcnt lgkmcnt(0)" ::: "memory");
}


__device__ __forceinline__ void cvb_emit(const f32x4 (&v)[8], int K, bf16_t* WT, LAS float* scr, int item, int nblk, int lane) {
    const int kb = item / nblk, nb = item - kb * nblk, k0 = 64 * kb, n0 = 32 * nb;
    { LAS float* d = scr + (lane >> 3) * 33 + (lane & 7) * 4;
#pragma unroll
      for (int i = 0; i < 8; ++i) { d[(8 * i) * 33 + 0] = v[i][0]; d[(8 * i) * 33 + 1] = v[i][1]; d[(8 * i) * 33 + 2] = v[i][2]; d[(8 * i) * 33 + 3] = v[i][3]; } }
    asm volatile("s_waitcnt lgkmcnt(0)" ::: "memory");
    const int c = lane & 7;
#pragma unroll
    for (int j = 0; j < 4; ++j) { const int n = (lane >> 3) + 8 * j; const LAS float* s = scr + (8 * c) * 33 + n;
        u32x4 o; o.x = pk2(s[0 * 33], s[1 * 33]); o.y = pk2(s[2 * 33], s[3 * 33]); o.z = pk2(s[4 * 33], s[5 * 33]); o.w = pk2(s[6 * 33], s[7 * 33]);
        *(u32x4*)(WT + (size_t)(n0 + n) * K + k0 + 8 * c) = o; }
    asm volatile("s_waitcnt lgkmcnt(0)" ::: "memory");
}

__device__ __forceinline__ unsigned pack4_i8(float a, float b, float c, float d) {
    return ((unsigned)(int)__builtin_rintf(a) & 0xffu) | (((unsigned)(int)__builtin_rintf(b) & 0xffu) << 8) | (((unsigned)(int)__builtin_rintf(c) & 0xffu) << 16) | (((unsigned)(int)__builtin_rintf(d) & 0xffu) << 24);
}
__device__ __forceinline__ void transpose_item_i8(const float* W, int K, int N, signed char* WT, float* wsc, const float* wpm, int NC, LAS float* scr, int item, int lane) {
    const int nblk = N / 32, kb = item / nblk, nb = item % nblk, k0 = 64 * kb, n0 = 32 * nb;
#pragma unroll 8
    for (int i = 0; i < 32; ++i) { const int kk = 2 * i + (lane >> 5); scr[kk * 33 + (lane & 31)] = W[(size_t)(k0 + kk) * N + n0 + (lane & 31)]; }
    asm volatile("s_waitcnt lgkmcnt(0)" ::: "memory");
    const int c = lane & 3;
#pragma unroll
    for (int jj = 0; jj < 2; ++jj) { const int n = (lane >> 2) + 16 * jj; const LAS float* sp = scr + (16 * c) * 33 + n;
        float mx = 0.f;
#pragma unroll
        for (int q = 0; q < 16; ++q) mx = fmaxf(mx, wpm[(size_t)q * NC + n0 + n]);
        const float sv = mx * (1.0f / 127.0f); const float inv = sv > 0.f ? 1.0f / sv : 0.f;
        if (kb == 0 && c == 0) wsc[n0 + n] = sv;
        u32x4 o;
        o.x = pack4_i8(inv * sp[0 * 33], inv * sp[1 * 33], inv * sp[2 * 33], inv * sp[3 * 33]);     o.y = pack4_i8(inv * sp[4 * 33], inv * sp[5 * 33], inv * sp[6 * 33], inv * sp[7 * 33]);
        o.z = pack4_i8(inv * sp[8 * 33], inv * sp[9 * 33], inv * sp[10 * 33], inv * sp[11 * 33]);   o.w = pack4_i8(inv * sp[12 * 33], inv * sp[13 * 33], inv * sp[14 * 33], inv * sp[15 * 33]);
        *(u32x4*)(WT + (size_t)(n0 + n) * K + k0 + 16 * c) = o; }
    asm volatile("s_waitcnt lgkmcnt(0)" ::: "memory");
}
__device__ __forceinline__ void cvt_i8_seg(const float* W, signed char* WT, float* wsc, const float* wpm, int K, int N, int nmat, LAS float* scr, int gw, int ngw, int lane) {
    const int per = (K / 64) * (N / 32), total = per * nmat;
    for (int it = gw; it < total; it += ngw) { const int mi = it / per; transpose_item_i8(W + (size_t)mi * K * N, K, N, WT + (size_t)mi * K * N, wsc + (size_t)mi * N, wpm + (size_t)mi * N, N * nmat, scr, it - mi * per, lane); }
}
__device__ __forceinline__ void colscale_seg(const float* W, float* wpm, int K, int N, int nmat, int gtid, int ngt) {
    const int NC = N * nmat;
    for (int idx = gtid; idx < NC * (K / 64); idx += ngt) { const int ksp = idx / NC, cix = idx - ksp * NC, mi = cix / N, n = cix - mi * N; const float* w = W + ((size_t)mi * K + (size_t)ksp * 64) * N + n; float mx = 0.f;
        for (int k0 = 0; k0 < 64; k0 += 16) { float v[16];
#pragma unroll
            for (int u = 0; u < 16; ++u) v[u] = w[(size_t)(k0 + u) * N];
#pragma unroll
            for (int u = 0; u < 16; ++u) mx = fmaxf(mx, fabsf(v[u])); }
        wpm[idx] = mx; }
}

__device__ __forceinline__ void cvt_i8_panels(const float* W, signed char* WT, float* wsc, LAS unsigned char* lds, int bid, int G, int tid) {
    LAS float* tile = (LAS float*)lds;
    LAS float* cmx = tile + 1024 * 33;
    for (int panel = bid; panel < 256; panel += G) {
        const int mi = panel >> 7, n0 = (panel & 127) * 32, cc = tid & 31, rr = tid >> 5;
        const float* src = W + (size_t)mi * 1024 * 4096 + n0 + cc;
        for (int r0 = 0; r0 < 1024; r0 += 256) {
            float v[16];
#pragma unroll
            for (int u = 0; u < 16; ++u) v[u] = src[(size_t)(r0 + u * 16 + rr) * 4096];
#pragma unroll
            for (int u = 0; u < 16; ++u) tile[(r0 + u * 16 + rr) * 33 + cc] = v[u];
        }
        __syncthreads();
        { float mx = 0.f;
#pragma unroll 16
          for (int u = 0; u < 64; ++u) mx = fmaxf(mx, fabsf(tile[(rr * 64 + u) * 33 + cc]));
          cmx[rr * 32 + cc] = mx; }
        __syncthreads();
        if (tid < 32) { float mx = 0.f;
#pragma unroll
            for (int q = 0; q < 16; ++q) mx = fmaxf(mx, cmx[q * 32 + tid]);
            const float sv = mx * (1.0f / 127.0f); cmx[512 + tid] = sv; wsc[(size_t)mi * 4096 + n0 + tid] = sv; }
        __syncthreads();
        { const float sv = cmx[512 + cc]; const float inv = sv > 0.f ? 1.0f / sv : 0.f;
          signed char* dst = WT + ((size_t)mi * 4096 + n0 + cc) * 1024;
#pragma unroll
          for (int j = 0; j < 4; ++j) { const int ck = rr + 16 * j; const LAS float* sp = tile + (16 * ck) * 33 + cc;
              u32x4 o;
              o.x = pack4_i8(inv * sp[0 * 33], inv * sp[1 * 33], inv * sp[2 * 33], inv * sp[3 * 33]);     o.y = pack4_i8(inv * sp[4 * 33], inv * sp[5 * 33], inv * sp[6 * 33], inv * sp[7 * 33]);
              o.z = pack4_i8(inv * sp[8 * 33], inv * sp[9 * 33], inv * sp[10 * 33], inv * sp[11 * 33]);   o.w = pack4_i8(inv * sp[12 * 33], inv * sp[13 * 33], inv * sp[14 * 33], inv * sp[15 * 33]);
              *(u32x4*)(dst + 16 * ck) = o; } }
        __syncthreads();
    }
}

typedef float f32x16 __attribute__((ext_vector_type(16)));
constexpr int XB_STRIDE = 272, XB_BYTES = 256 * XB_STRIDE, HF_STRIDE = 260, HF_BYTES = 256 * HF_STRIDE;
constexpr int NCK128 = NTOK / 128;
struct LruW { const bf16_t* wt_a; const bf16_t* wt_x; };

template <int D> __device__ __forceinline__ void lru_dir(const P& p, const LruW& W, int jl, int h, int row0, LAS unsigned char* xb, LAS unsigned char* hfb, int wn, int wm, int c, int q, int lane) {
    const int j = 32 * wn + c, ch = h * 128 + j;
    const float ba = p.lru_b_a[(jl * 2 + D) * LW + ch], bx = p.lru_b_x[(jl * 2 + D) * LW + ch];
    const float k2 = p.k2tab[(jl * 2 + D) * LW + ch];
    const float nba = -1.44269504089f * ba, nbx = -1.44269504089f * bx;
    bf16x8 Ba[8], Bx[8];
    {
        const bf16_t* ga = W.wt_a + ((size_t)((jl * 2 + D) * 10 + h) * 128 + j) * 128 + 8 * q;
        const bf16_t* gx = W.wt_x + ((size_t)((jl * 2 + D) * 10 + h) * 128 + j) * 128 + 8 * q;
#pragma unroll
        for (int s = 0; s < 8; ++s) { Ba[s] = *(const bf16x8*)(ga + 16 * s); Bx[s] = *(const bf16x8*)(gx + 16 * s); }
    }
    float Hc = 0.f, Cc = 1.f;
    const bool first = (D == 0) ? (q == 0) : (q == 1);
    for (int mi = 0; mi < 4; ++mi) {
        const int m = (D == 0) ? mi : 3 - mi;
        f32x16 aa, ax;
#pragma unroll
        for (int r = 0; r < 16; ++r) { aa[r] = 0.f; ax[r] = 0.f; }
        const LAS unsigned char* arow = xb + (wm * 128 + m * 32 + (lane & 31)) * XB_STRIDE + 16 * q;
#pragma unroll
        for (int s = 0; s < 8; ++s) {
            const bf16x8 af = *(const LAS bf16x8*)(arow + 32 * s);
            aa = __builtin_amdgcn_mfma_f32_32x32x16_bf16(af, Ba[s], aa, 0, 0, 0);
            ax = __builtin_amdgcn_mfma_f32_32x32x16_bf16(af, Bx[s], ax, 0, 0, 0);
        }
        const LAS unsigned char* xcol = xb + (wm * 128 + m * 32 + 4 * q) * XB_STRIDE + j * 2;
        float hL = 0.f, cL = 1.f;
#pragma unroll
        for (int rr = 0; rr < 16; rr += 2) {
            const int rl = (D == 0) ? rr : 14 - rr;
            f32x2 xv2, za, zx;
#pragma unroll
            for (int t2 = 0; t2 < 2; ++t2) { const int r = rl + t2, i0 = (r & 3) + 8 * (r >> 2);
                xv2[t2] = __uint_as_float(((unsigned)*(const LAS unsigned short*)(xcol + i0 * XB_STRIDE)) << 16); za[t2] = aa[r]; zx[t2] = ax[r]; }
            const f32x2 nl2 = {-1.44269504089f, -1.44269504089f};
            za = __builtin_elementwise_fma(za, nl2, (f32x2){nba, nba});
            zx = __builtin_elementwise_fma(zx, nl2, (f32x2){nbx, nbx});
            f32x2 da, dx; da[0] = __builtin_amdgcn_exp2f(za[0]); da[1] = __builtin_amdgcn_exp2f(za[1]); dx[0] = __builtin_amdgcn_exp2f(zx[0]); dx[1] = __builtin_amdgcn_exp2f(zx[1]);
            da = da + 1.0f; dx = dx + 1.0f;
            f32x2 rg, ig; rg[0] = __builtin_amdgcn_rcpf(da[0]); rg[1] = __builtin_amdgcn_rcpf(da[1]); ig[0] = __builtin_amdgcn_rcpf(dx[0]); ig[1] = __builtin_amdgcn_rcpf(dx[1]);
            const f32x2 l2 = rg * k2;
            f32x2 a2; a2[0] = __builtin_amdgcn_exp2f(l2[0]); a2[1] = __builtin_amdgcn_exp2f(l2[1]);
            const f32x2 om = __builtin_elementwise_fma(-a2, a2, (f32x2){1.0f, 1.0f});
            f32x2 sq; sq[0] = __builtin_amdgcn_sqrtf(om[0]); sq[1] = __builtin_amdgcn_sqrtf(om[1]);
            const f32x2 u2 = sq * (ig * xv2);
#pragma unroll
            for (int t2 = 0; t2 < 2; ++t2) { const int q2 = (D == 0) ? t2 : 1 - t2, r = rl + q2;
                hL = a2[q2] * hL + u2[q2]; cL *= a2[q2];
                ax[r] = hL; aa[r] = cL; }
        }
        const float Ao = shx(cL, 32, lane), Ho = shx(hL, 32, lane);
        const float A_f = first ? cL : Ao, H_f = first ? hL : Ho, A_s = first ? Ao : cL, H_s = first ? Ho : hL;
        const float mid = A_f * Hc + H_f;
        const float cin = first ? Hc : mid, cpre = first ? Cc : Cc * A_f;
        Hc = A_s * mid + H_s; Cc = Cc * A_f * A_s;
        const int trow = wm * 128 + m * 32 + q * 16;
        const int odd = lane & 1;
        unsigned char* gA = ((D == 0) ? p.Af : p.Ab) + (size_t)(row0 + trow + odd) * LW + (ch - odd);
        bf16_t* gS = p.S + (size_t)(row0 + trow) * LW + ch;
        LAS unsigned char* hrow = hfb + trow * HF_STRIDE + j * 2;
        const float cpre255 = cpre * 255.0f;
#pragma unroll
        for (int r = 0; r < 16; r += 2) {
            const float cv0 = __builtin_rintf(aa[r] * cpre255), cv1 = __builtin_rintf(aa[r + 1] * cpre255);
            const float send = odd ? cv0 : cv1; const float recv = __int_as_float(__builtin_amdgcn_mov_dpp(__float_as_int(send), 0xB1, 0xF, 0xF, true));
            unsigned pk = __builtin_amdgcn_cvt_pk_u8_f32(odd ? recv : cv0, 0, 0u); pk = __builtin_amdgcn_cvt_pk_u8_f32(odd ? cv1 : recv, 1, pk);
            *(unsigned short*)(gA + (size_t)r * LW) = (unsigned short)pk;
        }
#pragma unroll
        for (int r = 0; r < 16; ++r) {
            const float hv = ax[r] + aa[r] * cin;
            if (D == 0) *(LAS unsigned short*)(hrow + r * HF_STRIDE) = f2bf(hv);
            else { const float hf = __uint_as_float(((unsigned)*(const LAS unsigned short*)(hrow + r * HF_STRIDE)) << 16); gS[(size_t)r * LW] = f2bf(hv + hf); }
        }
    }
    if (q == 0) { const int ck128 = (row0 >> 7) + wm; float* ag = p.agg + ((size_t)(ck128 * 2 + D) * 2) * LW + ch; ag[0] = Cc; ag[LW] = Hc; }
}

__device__ __forceinline__ void lru_scan_phase(const P& p, const LruW& W, int jl, LAS unsigned char* lds, int wv) {
    const Ids I = fresh_ids(wv); const int tid = I.tid, lane = I.lane, wid = I.wid, wn = wid & 3, wm = wid >> 2, c = lane & 31, q = lane >> 5;
    LAS unsigned char* xb = lds; LAS unsigned char* hfb = lds + XB_BYTES;
    for (int u = I.bid; u < NCK * 10; u += I.G) {
        const int ck = u / 10, h = u - ck * 10, row0 = ck * 256;
        int t0, T; if (ck < 32) { t0 = 0; T = 256; } else { t0 = ((ck - 32) & 15) * 256; T = 4096; }
        {
            const int chunk = tid & 15, g = tid >> 4, ch0 = h * 128 + chunk * 8;
            const float* cw = p.lru_conv_w + (size_t)jl * 4 * LW + ch0; const float* cbp = p.lru_conv_b + jl * LW + ch0;
            float w[4][8], b[8];
#pragma unroll
            for (int k = 0; k < 4; ++k) { const float4 lo = *(const float4*)(cw + k * LW), hi = *(const float4*)(cw + k * LW + 4); w[k][0] = lo.x; w[k][1] = lo.y; w[k][2] = lo.z; w[k][3] = lo.w; w[k][4] = hi.x; w[k][5] = hi.y; w[k][6] = hi.z; w[k][7] = hi.w; }
            { const float4 lo = *(const float4*)cbp, hi = *(const float4*)(cbp + 4); b[0] = lo.x; b[1] = lo.y; b[2] = lo.z; b[3] = lo.w; b[4] = hi.x; b[5] = hi.y; b[6] = hi.z; b[7] = hi.w; }
            uint4 raw[11];
#pragma unroll
            for (int k = 0; k < 11; ++k) { const int tl = g * 8 + k - 2, tt = t0 + tl; raw[k] = make_uint4(0u, 0u, 0u, 0u);
                if (tt >= 0 && tt < T) raw[k] = *(const uint4*)(p.xpre + (size_t)(row0 + tl) * LW + ch0); }
            asm volatile("" ::: "memory");
#pragma unroll
            for (int k = 0; k < 8; ++k) {
                float o[8];
#pragma unroll
                for (int e = 0; e < 8; ++e) o[e] = b[e];
#pragma unroll
                for (int tap = 0; tap < 4; ++tap) { const uint4 rw = raw[k + tap]; const unsigned ww[4] = {rw.x, rw.y, rw.z, rw.w};
#pragma unroll
                    for (int e2 = 0; e2 < 4; ++e2) { o[2 * e2] += w[tap][2 * e2] * __uint_as_float(ww[e2] << 16); o[2 * e2 + 1] += w[tap][2 * e2 + 1] * __uint_as_float(ww[e2] & 0xffff0000u); } }
                const int Tt = g * 8 + k, wmm = Tt >> 7, tl = Tt & 127, mm = tl >> 5, qq = (tl >> 4) & 1, r = tl & 15, i = (r & 3) + 8 * (r >> 2) + 4 * qq;
                u32x4 pk; pk.x = pk2(o[0], o[1]); pk.y = pk2(o[2], o[3]); pk.z = pk2(o[4], o[5]); pk.w = pk2(o[6], o[7]);
                *(LAS u32x4*)(xb + (wmm * 128 + mm * 32 + i) * XB_STRIDE + chunk * 16) = pk;
            }
        }
        __syncthreads();
        lru_dir<0>(p, W, jl, h, row0, xb, hfb, wn, wm, c, q, lane);
        lru_dir<1>(p, W, jl, h, row0, xb, hfb, wn, wm, c, q, lane);
        __syncthreads();
    }
}
__device__ __forceinline__ void lru_fix_phase(const P& p, int jl, int wv) {
    const Ids I = fresh_ids(wv);
    for (int it = I.bid * 512 + I.tid; it < NCK128 * 4 * 160; it += I.G * 512) {
        const int cg = it % 160, rq = (it / 160) & 3, ck = it / 640, ch0 = cg * 8;
        int seq, pos, nch, base; bool smp = ck >= 64;
        if (!smp) { seq = ck >> 1; pos = ck & 1; nch = 2; base = seq * 2; } else { const int c2 = ck - 64; seq = c2 >> 5; pos = c2 & 31; nch = 32; base = 64 + seq * 32; }
        float cf[8], cb[8];
#pragma unroll
        for (int e = 0; e < 8; ++e) { cf[e] = 0.f; cb[e] = 0.f; }
        if (smp) { const float* s0 = p.state_lru + ((size_t)(seq * 2 + jl) * 2) * LW + ch0;
#pragma unroll
            for (int e = 0; e < 8; ++e) { cf[e] = s0[e]; cb[e] = s0[LW + e]; } }
        for (int k = 0; k < pos; ++k) { const float* a = p.agg + ((size_t)((base + k) * 2 + 0) * 2) * LW + ch0;
#pragma unroll
            for (int e = 0; e < 8; ++e) cf[e] = a[e] * cf[e] + a[LW + e]; }
        for (int k = nch - 1; k > pos; --k) { const float* a = p.agg + ((size_t)((base + k) * 2 + 1) * 2) * LW + ch0;
#pragma unroll
            for (int e = 0; e < 8; ++e) cb[e] = a[e] * cb[e] + a[LW + e]; }
        if (!smp && rq == 0) {
            const float* a = p.agg + ((size_t)(ck * 2 + (pos ? 0 : 1)) * 2) * LW + ch0;
            float* ns = p.new_state + ((size_t)(seq * 2 + jl) * 2 + (pos ? 0 : 1)) * LW + ch0;
#pragma unroll
            for (int e = 0; e < 8; ++e) ns[e] = a[e] * (pos ? cf[e] : cb[e]) + a[LW + e];
        }
        const size_t o0 = (size_t)(ck * 128 + rq * 32) * LW + ch0;
#pragma unroll
        for (int e = 0; e < 8; ++e) { cf[e] *= (1.0f / 255.0f); cb[e] *= (1.0f / 255.0f); }
        for (int t = 0; t < 32; ++t) { const size_t o = o0 + (size_t)t * LW;
            const uint4 s = *(const uint4*)(p.S + o), gt = *(const uint4*)(p.gate + o); const u32x2 af = *(const u32x2*)(p.Af + o), ab = *(const u32x2*)(p.Ab + o);
            const unsigned sw[4] = {s.x, s.y, s.z, s.w}, gw[4] = {gt.x, gt.y, gt.z, gt.w};
            unsigned ow[4];
#pragma unroll
            for (int e2 = 0; e2 < 4; ++e2) {
                const unsigned fq = af[e2 >> 1] >> (16 * (e2 & 1)), bq = ab[e2 >> 1] >> (16 * (e2 & 1));
                const float lo = (__uint_as_float(sw[e2] << 16) + (float)(fq & 0xffu) * cf[2 * e2] + (float)(bq & 0xffu) * cb[2 * e2]) * __uint_as_float(gw[e2] << 16);
                const float hi = (__uint_as_float(sw[e2] & 0xffff0000u) + (float)((fq >> 8) & 0xffu) * cf[2 * e2 + 1] + (float)((bq >> 8) & 0xffu) * cb[2 * e2 + 1]) * __uint_as_float(gw[e2] & 0xffff0000u);
                ow[e2] = pk2(lo, hi); }
            *(uint4*)(p.zl + o) = make_uint4(ow[0], ow[1], ow[2], ow[3]); }
    }
}
typedef short s16x4 __attribute__((ext_vector_type(4)));
__device__ __forceinline__ unsigned off_b(unsigned row, unsigned ch) { return 256u * row + 16u * (ch ^ (((row & 3) << 2) | ((row >> 2) & 3))); }
__device__ __forceinline__ unsigned tr_read_addr(unsigned lane, unsigned c, unsigned ks, unsigned t) {
    const unsigned h = lane >> 5, blk = (lane >> 4) & 1, q = (lane & 15) >> 2, pp = lane & 3;
    return off_b(16 * ks + 8 * h + 4 * t + q, 4 * c + 2 * blk + (pp >> 1)) + 8 * (pp & 1);
}
__device__ __forceinline__ void sgu_phase(const P& p, int jl, LAS unsigned char* lds, int wv) {
    const Ids I = fresh_ids(wv); const int tid = I.tid, lane = I.lane, wid = I.wid;
    LAS unsigned char* Aimg = lds; LAS unsigned char* Vimg = lds + 32768; LAS unsigned char* stage = lds;
    LAS float* rsb = (LAS float*)(lds + 98304); LAS float* bsl = rsb + 256;
    constexpr int NU = (NTOK / 128) * 8, SST = 528;
    u32x4 vreg[8], ureg[8]; float4 wlo[4], whi[4];
    int u = I.bid;
    if (u >= NU) return;
    const unsigned vo_v = (unsigned)((tid >> 5) * 8192 + (tid & 31) * 16), vo_z = (unsigned)((tid >> 5) * 4096 + (tid & 31) * 16), vo_w = (unsigned)(((tid >> 4) * 128 + (tid & 15) * 8) * 4);
#define SG_ISSUE(uu) do { const int n_ = (uu) >> 3, g_ = (uu) & 7; const char* vb_ = (const char*)(p.proj + (size_t)n_ * 128 * 4096 + 2048 + g_ * 256); const char* wb_ = (const char*)(p.sg_w_s + (size_t)(jl * 8 + g_) * 128 * 128); \
        _Pragma("unroll") for (int k = 0; k < 8; ++k) vreg[k] = *(const u32x4*)(vb_ + (size_t)k * 16 * 8192 + vo_v); \
        _Pragma("unroll") for (int k = 0; k < 4; ++k) { const char* wk_ = wb_ + (size_t)k * 32 * 512 + vo_w; wlo[k] = *(const float4*)wk_; whi[k] = *(const float4*)(wk_ + 16); } } while (0)
#define SG_RS(uu, bf) do { if (tid < 128) { const int n_ = (uu) >> 3, g_ = (uu) & 7; const float4* vp = (const float4*)(p.vss + (size_t)(n_ * 128 + tid) * 32); float sacc = 0.f; \
        _Pragma("unroll") for (int k = 0; k < 8; ++k) { const float4 v = vp[k]; sacc += (v.x + v.y) + (v.z + v.w); } \
        rsb[(bf) * 128 + tid] = rsqrtf(sacc * (1.0f / 2048.0f) + RMS_EPS); bsl[(bf) * 128 + tid] = p.sg_b_s[(jl * 8 + g_) * 128 + tid]; } } while (0)
    SG_ISSUE(u); SG_RS(u, 0);
    int buf = 0;
    for (; u < NU; u += I.G) {
        const int n = u >> 3, g = u & 7, row0 = n * 128;
        __syncthreads();
#pragma unroll
        for (int k = 0; k < 8; ++k) { const int it = tid + 512 * k, qq = it >> 5, cch = it & 31; *(LAS u32x4*)(Vimg + (cch >> 4) * 32768 + off_b(qq, cch & 15)) = vreg[k]; }
#pragma unroll
        for (int k = 0; k < 4; ++k) { const int it = tid + 512 * k, pp = it >> 4, chq = it & 15; const LAS float* r8 = rsb + buf * 128 + chq * 8;
            u32x4 pk; pk.x = pk2(wlo[k].x * r8[0], wlo[k].y * r8[1]); pk.y = pk2(wlo[k].z * r8[2], wlo[k].w * r8[3]); pk.z = pk2(whi[k].x * r8[4], whi[k].y * r8[5]); pk.w = pk2(whi[k].z * r8[6], whi[k].w * r8[7]);
            *(LAS u32x4*)(Aimg + off_b(pp, chq)) = pk; }
#pragma unroll
        for (int k = 0; k < 8; ++k) ureg[k] = *(const u32x4*)((const char*)(p.proj + (size_t)row0 * 4096 + g * 256) + (size_t)k * 16 * 8192 + vo_v);
        const int gcol = g * 256 + 32 * wid + (lane & 31); const float ng = p.sg_norm_g[jl * SGW + gcol];
        __syncthreads();
        f32x16 acc[4];
#pragma unroll
        for (int m = 0; m < 4; ++m)
#pragma unroll
            for (int r = 0; r < 16; ++r) acc[m][r] = 0.f;
        const LAS unsigned char* vb = Vimg + (wid >> 2) * 32768; const unsigned cblk = wid & 3;
#pragma unroll
        for (int s2 = 0; s2 < 8; ++s2) {
            const s16x4 b0 = __builtin_amdgcn_ds_read_tr16_b64_v4i16((LAS s16x4*)(vb + tr_read_addr(lane, cblk, s2, 0)));
            const s16x4 b1 = __builtin_amdgcn_ds_read_tr16_b64_v4i16((LAS s16x4*)(vb + tr_read_addr(lane, cblk, s2, 1)));
            bf16x8 B; B[0] = b0[0]; B[1] = b0[1]; B[2] = b0[2]; B[3] = b0[3]; B[4] = b1[0]; B[5] = b1[1]; B[6] = b1[2]; B[7] = b1[3];
#pragma unroll
            for (int m = 0; m < 4; ++m) { const bf16x8 A = *(const LAS bf16x8*)(Aimg + off_b(32 * m + (lane & 31), 2 * s2 + (lane >> 5))); acc[m] = __builtin_amdgcn_mfma_f32_32x32x16_bf16(A, B, acc[m], 0, 0, 0); }
        }
        __syncthreads();
        { LAS unsigned char* scol = stage + (32 * wid + (lane & 31)) * 2; const LAS float* bb = bsl + buf * 128;
#pragma unroll
          for (int m = 0; m < 4; ++m)
#pragma unroll
            for (int r = 0; r < 16; ++r) { const int pp = 32 * m + (r & 3) + 8 * (r >> 2) + 4 * (lane >> 5);
                *(LAS unsigned short*)(scol + pp * SST) = f2bf(acc[m][r] * ng + bb[pp]); } }
        const int un = u + I.G;
        if (un < NU) { SG_ISSUE(un); SG_RS(un, buf ^ 1); }
        __syncthreads();
#pragma unroll
        for (int k = 0; k < 8; ++k) { const int it = tid + 512 * k, pp = it >> 5, cch = it & 31;
            const u32x4 sv = *(const LAS u32x4*)(stage + pp * SST + cch * 16); const u32x4 uu = ureg[k]; u32x4 o;
            o.x = pk2(__uint_as_float(sv.x << 16) * __uint_as_float(uu.x << 16), __uint_as_float(sv.x & 0xffff0000u) * __uint_as_float(uu.x & 0xffff0000u));
            o.y = pk2(__uint_as_float(sv.y << 16) * __uint_as_float(uu.y << 16), __uint_as_float(sv.y & 0xffff0000u) * __uint_as_float(uu.y & 0xffff0000u));
            o.z = pk2(__uint_as_float(sv.z << 16) * __uint_as_float(uu.z << 16), __uint_as_float(sv.z & 0xffff0000u) * __uint_as_float(uu.z & 0xffff0000u));
            o.w = pk2(__uint_as_float(sv.w << 16) * __uint_as_float(uu.w << 16), __uint_as_float(sv.w & 0xffff0000u) * __uint_as_float(uu.w & 0xffff0000u));
            *(u32x4*)((char*)(p.zsg + (size_t)row0 * SGW + g * 256) + (size_t)k * 16 * 4096 + vo_z) = o; }
        buf ^= 1;
    }
#undef SG_ISSUE
#undef SG_RS
}


#define PIN8(a, b, c, d, e, f, g, h) asm volatile("" : "+v"(a), "+v"(b), "+v"(c), "+v"(d), "+v"(e), "+v"(f), "+v"(g), "+v"(h) :: "memory")
#define PIN4(a, b, c, d) asm volatile("" : "+v"(a), "+v"(b), "+v"(c), "+v"(d) :: "memory")

__device__ __forceinline__ void rowA_phase(const P& p, int l, int wv, bool dry = false) {
    const Ids I = fresh_ids(wv); const int lane = I.lane;
    constexpr int NPAIR = NTOK / 2;
    int pr = I.gw, s_cur = -1;
    float pfreq[4];
#pragma unroll
    for (int q = 0; q < 4; ++q) pfreq[q] = (l == 0) ? expf(-9.210340371976184f * (float)(4 * lane + q) / 256.0f) : 0.f;
    if (l > 0 && pr < NPAIR && lane < 32) s_cur = p.inv[(size_t)(lane & 15) * NTOK + 2 * pr + (lane >> 4)];
    for (; pr < NPAIR; pr += I.ngw) {
        const int r0 = 2 * pr, ci = tok_cond(r0), prn = pr + I.ngw;
        int s_nxt = -1;
        if (l > 0 && prn < NPAIR && lane < 32) s_nxt = p.inv[(size_t)(lane & 15) * NTOK + 2 * prn + (lane >> 4)];
        float4 xv[2][4];
        if (l == 0) {
#pragma unroll
            for (int rr = 0; rr < 2; ++rr) { const int r = r0 + rr;
                if (r < NCTX) {
#pragma unroll
                    for (int j = 0; j < 4; ++j) xv[rr][j] = *(const float4*)(p.x_prompt + (size_t)r * DM + 4 * lane + 256 * j);
                } else {
                    const int rs = r - NCTX, t = rs & 4095; const float frow = (float)(t >> 6), fcol = (float)(t & 63);
#pragma unroll
                    for (int j = 0; j < 4; ++j) {
                        float4 v = *(const float4*)(p.x_sample + (size_t)rs * DM + 4 * lane + 256 * j);
                        float e[4];
#pragma unroll
                        for (int q = 0; q < 4; ++q) { const float ang = (j < 2 ? frow : fcol) * pfreq[q]; e[q] = (j & 1) ? __cosf(ang) : __sinf(ang); }
                        v.x += e[0]; v.y += e[1]; v.z += e[2]; v.w += e[3]; xv[rr][j] = v;
                    }
                }
            }
        } else {
            u32x2 xr4[2][4];
#pragma unroll
            for (int rr = 0; rr < 2; ++rr)
#pragma unroll
                for (int j = 0; j < 4; ++j) xr4[rr][j] = *(const u32x2*)(p.x + (size_t)(r0 + rr) * DM + 4 * lane + 256 * j);
            const unsigned long long bal = __ballot(s_cur >= 0);
            unsigned buf[2][4][4]; unsigned nsel[2], rem[2];
#pragma unroll
            for (int rr = 0; rr < 2; ++rr) {
                unsigned m = (unsigned)__builtin_amdgcn_readfirstlane((int)((bal >> (16 * rr)) & 0xffffull)); nsel[rr] = (unsigned)__builtin_popcount(m);
#pragma unroll
                for (int k = 0; k < 4; ++k) if (m) { const int e = __builtin_ctz(m); m &= m - 1u; const int slot = __builtin_amdgcn_readlane(s_cur, 16 * rr + e);
                    const unsigned char* orow = p.outm + (size_t)slot * DM + 4 * lane;
#pragma unroll
                    for (int j = 0; j < 4; ++j) buf[rr][k][j] = *(const unsigned*)(orow + 256 * j); }
                rem[rr] = m;
            }
            PIN8(xr4[0][0], xr4[0][1], xr4[0][2], xr4[0][3], xr4[1][0], xr4[1][1], xr4[1][2], xr4[1][3]);
#pragma unroll
            for (int rr = 0; rr < 2; ++rr)
#pragma unroll
                for (int k = 0; k < 4; k += 2) PIN8(buf[rr][k][0], buf[rr][k][1], buf[rr][k][2], buf[rr][k][3], buf[rr][k + 1][0], buf[rr][k + 1][1], buf[rr][k + 1][2], buf[rr][k + 1][3]);
#pragma unroll
            for (int rr = 0; rr < 2; ++rr)
#pragma unroll
                for (int j = 0; j < 4; ++j) xv[rr][j] = xs_unpack(xr4[rr][j]);
            const float* g2 = p.mod + (size_t)((l - 1) * 9 + ci) * 6144 + 5 * 1024;
#pragma unroll
            for (int rr = 0; rr < 2; ++rr) {
                float4 acc[4];
#pragma unroll
                for (int j = 0; j < 4; ++j) acc[j] = make_float4(0.f, 0.f, 0.f, 0.f);
#pragma unroll
                for (int k = 0; k < 4; ++k) if (nsel[rr] > (unsigned)k) {
#pragma unroll
                    for (int j = 0; j < 4; ++j) { const f32x2 lo = __builtin_amdgcn_cvt_pk_f32_fp8((int)buf[rr][k][j], false), hi = __builtin_amdgcn_cvt_pk_f32_fp8((int)buf[rr][k][j], true); acc[j].x += lo[0]; acc[j].y += lo[1]; acc[j].z += hi[0]; acc[j].w += hi[1]; } }
                unsigned m = rem[rr];
                while (m) { const int e = __builtin_ctz(m); m &= m - 1u; const int slot = __builtin_amdgcn_readlane(s_cur, 16 * rr + e); const unsigned char* orow = p.outm + (size_t)slot * DM + 4 * lane;
#pragma unroll
                    for (int j = 0; j < 4; ++j) { const unsigned w = *(const unsigned*)(orow + 256 * j); const f32x2 lo = __builtin_amdgcn_cvt_pk_f32_fp8((int)w, false), hi = __builtin_amdgcn_cvt_pk_f32_fp8((int)w, true); acc[j].x += lo[0]; acc[j].y += lo[1]; acc[j].z += hi[0]; acc[j].w += hi[1]; } }
#pragma unroll
                for (int j = 0; j < 4; ++j) { const float4 g = *(const float4*)(g2 + 4 * lane + 256 * j);
                    xv[rr][j].x += 0.0625f * g.x * acc[j].x; xv[rr][j].y += 0.0625f * g.y * acc[j].y; xv[rr][j].z += 0.0625f * g.z * acc[j].z; xv[rr][j].w += 0.0625f * g.w * acc[j].w; }
            }
        }
        const float* md = p.mod + (size_t)((l < 4 ? l : 0) * 9 + ci) * 6144;
        float4 gsv[4], shv[4];
        { f32x4 pg[4], psc[4], psh[4];
#pragma unroll
          for (int j = 0; j < 4; ++j) { const int c0 = 4 * lane + 256 * j;
            if (l < 4) { pg[j] = *(const f32x4*)(p.norm1_g + l * 1024 + c0); psc[j] = *(const f32x4*)(md + 1024 + c0); psh[j] = *(const f32x4*)(md + c0); }
            else { pg[j] = *(const f32x4*)(p.final_norm_g + c0); psc[j] = (f32x4){0.f, 0.f, 0.f, 0.f}; psh[j] = (f32x4){0.f, 0.f, 0.f, 0.f}; } }
          PIN8(pg[0], pg[1], pg[2], pg[3], psc[0], psc[1], psc[2], psc[3]); PIN4(psh[0], psh[1], psh[2], psh[3]);
#pragma unroll
          for (int j = 0; j < 4; ++j) { shv[j] = make_float4(psh[j][0], psh[j][1], psh[j][2], psh[j][3]);
            gsv[j] = make_float4(pg[j][0] * (1.f + psc[j][0]), pg[j][1] * (1.f + psc[j][1]), pg[j][2] * (1.f + psc[j][2]), pg[j][3] * (1.f + psc[j][3])); } }
#pragma unroll
        for (int rr = 0; rr < 2; ++rr) {
            const int r = r0 + rr; bf16_t* xw = (dry ? p.gate : p.x) + (size_t)r * DM;
            float ss = 0.f;
#pragma unroll
            for (int j = 0; j < 4; ++j) { if (l < 4) { const u32x2 o = xs_pack(xv[rr][j]); *(u32x2*)(xw + 4 * lane + 256 * j) = o; xv[rr][j] = xs_unpack(o); }
                ss += xv[rr][j].x * xv[rr][j].x + xv[rr][j].y * xv[rr][j].y + xv[rr][j].z * xv[rr][j].z + xv[rr][j].w * xv[rr][j].w; }
            ss = wave_sum(ss, lane);
            const float rstd = rsqrtf(ss * (1.0f / 1024.0f) + RMS_EPS);
            if (l < 4) {
                if (l & 1) {
                float4 hv[4]; float amax = 0.f;
#pragma unroll
                for (int j = 0; j < 4; ++j) { const float4 gs = gsv[j], sh = shv[j];
                    hv[j] = make_float4(xv[rr][j].x * rstd * gs.x + sh.x, xv[rr][j].y * rstd * gs.y + sh.y, xv[rr][j].z * rstd * gs.z + sh.z, xv[rr][j].w * rstd * gs.w + sh.w);
                    amax = fmaxf(fmaxf(amax, fmaxf(fabsf(hv[j].x), fabsf(hv[j].y))), fmaxf(fabsf(hv[j].z), fabsf(hv[j].w))); }
#pragma unroll
                for (int o = 32; o >= 1; o >>= 1) amax = fmaxf(amax, shx(amax, o, lane));
                const float inv = amax > 0.f ? 127.0f / amax : 0.f;
                if (lane == 0) p.hsc[r] = amax * (1.0f / 127.0f);
                signed char* hr = p.hn8i + (size_t)r * DM;
#pragma unroll
                for (int j = 0; j < 4; ++j) *(unsigned*)(hr + 4 * lane + 256 * j) = pack4_i8(inv * hv[j].x, inv * hv[j].y, inv * hv[j].z, inv * hv[j].w);
                } else {
                bf16_t* hr = p.hn + (size_t)r * DM;
#pragma unroll
                for (int j = 0; j < 4; ++j) { const int c0 = 4 * lane + 256 * j; const float4 gs = gsv[j], sh = shv[j];
                    const float a = xv[rr][j].x * rstd * gs.x + sh.x, b = xv[rr][j].y * rstd * gs.y + sh.y, c = xv[rr][j].z * rstd * gs.z + sh.z, d = xv[rr][j].w * rstd * gs.w + sh.w;
                    uint2 w; w.x = (unsigned)f2bf(a) | ((unsigned)f2bf(b) << 16); w.y = (unsigned)f2bf(c) | ((unsigned)f2bf(d) << 16);
                    *(uint2*)(hr + c0) = w; }
                }
            } else {
#pragma unroll
                for (int j = 0; j < 4; ++j) { const int c0 = 4 * lane + 256 * j; const float4 g = gsv[j];
                    float4 o; o.x = xv[rr][j].x * rstd * g.x; o.y = xv[rr][j].y * rstd * g.y; o.z = xv[rr][j].z * rstd * g.z; o.w = xv[rr][j].w * rstd * g.w;
                    *(float4*)((dry ? (float*)p.gate : p.xout) + (size_t)r * DM + c0) = o; }
            }
        }
        s_cur = s_nxt;
    }
}

__device__ __forceinline__ void rowB_phase(const P& p, int l, LAS unsigned char* lds, int wv, bool dry = false) {
    const Ids I = fresh_ids(wv); const int tid = I.tid, lane = I.lane, gw = I.gw, ngw = I.ngw;
    LAS float* rT = (LAS float*)lds;
    { const float* rt = p.moe_router + (size_t)l * 1024 * 16;
      f32x4 rv[8];
#pragma unroll
      for (int q = 0; q < 8; ++q) rv[q] = *(const f32x4*)(rt + 4 * (tid + 512 * q));
#pragma unroll
      for (int q = 0; q < 8; ++q) { const int i = 4 * (tid + 512 * q), k = i >> 4, e = i & 15;
          f32x2 lo2; lo2[0] = rv[q][0]; lo2[1] = rv[q][1]; f32x2 hi2; hi2[0] = rv[q][2]; hi2[1] = rv[q][3];
          const int sl = (k & 1) * 2, pl0 = (((e >> 1) * 2 + ((k >> 1) & 1)) * 256 + (k >> 2)) * 4 + sl, pl1 = ((((e >> 1) + 1) * 2 + ((k >> 1) & 1)) * 256 + (k >> 2)) * 4 + sl;
          *(LAS f32x2*)(rT + pl0) = lo2; *(LAS f32x2*)(rT + pl1) = hi2; } }
    __syncthreads();
    for (int grp = gw; grp < NTOK / 4; grp += ngw) {
        const int r0 = grp * 4, ci = tok_cond(r0);
        const float* md = p.mod + (size_t)(l * 9 + ci) * 6144;
        float4 xv[4][4]; float rstd[4];
        {
            u32x2 xr4[4][4];
#pragma unroll
            for (int rr = 0; rr < 4; ++rr)
#pragma unroll
                for (int j = 0; j < 4; ++j) xr4[rr][j] = *(const u32x2*)(p.x + (size_t)(r0 + rr) * DM + 4 * lane + 256 * j);
#pragma unroll
            for (int rr = 0; rr < 4; rr += 2) { PIN8(xr4[rr][0], xr4[rr][1], xr4[rr][2], xr4[rr][3], xr4[rr + 1][0], xr4[rr + 1][1], xr4[rr + 1][2], xr4[rr + 1][3]); }
#pragma unroll
            for (int rr = 0; rr < 4; ++rr)
#pragma unroll
                for (int j = 0; j < 4; ++j) xv[rr][j] = xs_unpack(xr4[rr][j]);
        }
        float4 gsv[4], shv[4];
        { f32x4 pg[4], psc[4], psh[4];
#pragma unroll
          for (int j = 0; j < 4; ++j) { const int c0 = 4 * lane + 256 * j; pg[j] = *(const f32x4*)(p.norm2_g + l * 1024 + c0); psc[j] = *(const f32x4*)(md + 4096 + c0); psh[j] = *(const f32x4*)(md + 3072 + c0); }
          PIN8(pg[0], pg[1], pg[2], pg[3], psc[0], psc[1], psc[2], psc[3]); PIN4(psh[0], psh[1], psh[2], psh[3]);
#pragma unroll
          for (int j = 0; j < 4; ++j) { shv[j] = make_float4(psh[j][0], psh[j][1], psh[j][2], psh[j][3]);
            gsv[j] = make_float4(pg[j][0] * (1.f + psc[j][0]), pg[j][1] * (1.f + psc[j][1]), pg[j][2] * (1.f + psc[j][2]), pg[j][3] * (1.f + psc[j][3])); } }
#pragma unroll
        for (int rr = 0; rr < 4; ++rr) { float ss = 0.f;
#pragma unroll
            for (int j = 0; j < 4; ++j) { const float4 v = xv[rr][j]; ss += v.x * v.x + v.y * v.y + v.z * v.z + v.w * v.w; }
            rstd[rr] = rsqrtf(wave_sum(ss, lane) * (1.0f / 1024.0f) + RMS_EPS);
        }
        float lg[64];
#pragma unroll
        for (int i = 0; i < 64; ++i) lg[i] = 0.f;
#pragma unroll
        for (int j = 0; j < 4; ++j) { const int c0 = 4 * lane + 256 * j;
            const float4 gs = gsv[j], sh = shv[j];
            float4 h[4];
#pragma unroll
            for (int rr = 0; rr < 4; ++rr) { const float4 v = xv[rr][j]; const float rs = rstd[rr];
                h[rr] = make_float4(v.x * rs * gs.x + sh.x, v.y * rs * gs.y + sh.y, v.z * rs * gs.z + sh.z, v.w * rs * gs.w + sh.w);
                *(unsigned*)(p.hn8 + (size_t)(r0 + rr) * DM + c0) = pg8::pack4_fp8(h[rr].x, h[rr].y, h[rr].z, h[rr].w); }
            if (!(dry && PROBE_KIND == 12))
#pragma unroll
            for (int eg = 0; eg < 4; ++eg) {
                f32x4 wa[2], wb[2];
#pragma unroll
                for (int q = 0; q < 2; ++q) { const int ep = eg * 2 + q, kg = c0 >> 2; wa[q] = *(const LAS f32x4*)(rT + ((ep * 2 + 0) * 256 + kg) * 4); wb[q] = *(const LAS f32x4*)(rT + ((ep * 2 + 1) * 256 + kg) * 4); }
#pragma unroll
                for (int q = 0; q < 2; ++q)
#pragma unroll
                    for (int rr = 0; rr < 4; ++rr) { const int li = rr * 16 + (eg * 2 + q) * 2;
                        f32x2 acc; acc[0] = lg[li]; acc[1] = lg[li + 1];
                        f32x2 w0; w0[0] = wa[q][0]; w0[1] = wa[q][1]; f32x2 w1; w1[0] = wa[q][2]; w1[1] = wa[q][3]; f32x2 w2; w2[0] = wb[q][0]; w2[1] = wb[q][1]; f32x2 w3; w3[0] = wb[q][2]; w3[1] = wb[q][3];
                        f32x2 hx; hx[0] = h[rr].x; hx[1] = h[rr].x; f32x2 hy; hy[0] = h[rr].y; hy[1] = h[rr].y; f32x2 hz; hz[0] = h[rr].z; hz[1] = h[rr].z; f32x2 hw; hw[0] = h[rr].w; hw[1] = h[rr].w;
                        acc = __builtin_elementwise_fma(hx, w0, acc); acc = __builtin_elementwise_fma(hy, w1, acc); acc = __builtin_elementwise_fma(hz, w2, acc); acc = __builtin_elementwise_fma(hw, w3, acc);
                        lg[li] = acc[0]; lg[li + 1] = acc[1]; }
                __builtin_amdgcn_sched_barrier(0);
            }
        }
#pragma unroll
        for (int n = 32; n >= 1; n >>= 1) { const bool hi = (lane & n) != 0;
#pragma unroll
            for (int i = 0; i < n; ++i) { const float send = hi ? lg[i] : lg[i + n]; const float recv = shx(send, n, lane); lg[i] = (hi ? lg[i + n] : lg[i]) + recv; } }
        const float v = lg[0];
        float mx = v;
#pragma unroll
        for (int o = 8; o >= 1; o >>= 1) mx = fmaxf(mx, shx(mx, o, lane));
        const float ex = __expf(v - mx); float sm = ex;
#pragma unroll
        for (int o = 8; o >= 1; o >>= 1) sm += shx(sm, o, lane);
        p.affT[(size_t)(lane & 15) * NTOK + r0 + (lane >> 4)] = ex / sm;
        if (PROBE_KIND >= 16 && PROBE_KIND <= 17) p.affT2[(size_t)(lane & 15) * NTOK + r0 + (lane >> 4)] = ex / sm;
    }
}

__device__ __forceinline__ void mod_phase(const P& p, LAS unsigned char* lds, int wv) {
    const Ids I = fresh_ids(wv); const int bid = I.bid, tid = I.tid;
    { const int i = bid * 512 + tid; if (i < 4 * LW) { const float lam = p.lru_lam[i]; const float sp = (-lam > 20.f) ? -lam : log1pf(expf(-lam)); p.k2tab[i] = -8.0f * sp * 1.44269504089f; } }
    LAS float* sc = (LAS float*)lds; LAS float* red = sc + 1024 * 12;
    for (int i = tid; i < 9 * 1024; i += 512) { const int ci = i >> 10, k = i & 1023; const float v = ci == 0 ? p.c_ctx[k] : p.c[(ci - 1) * 1024 + k]; sc[k * 12 + ci] = v / (1.0f + __expf(-v)); }
    __syncthreads();
    for (int unit = bid; unit < 256; unit += I.G) {
        const int l = unit >> 6, n0 = (unit & 63) * 96, col = tid % 96, ks = tid / 96;
        if (ks < 5) {
            float acc[9];
#pragma unroll
            for (int ci = 0; ci < 9; ++ci) acc[ci] = 0.f;
            const int kb = ks * 208, nk = ks == 4 ? 192 : 208;
            const float* w = p.w_mod + ((size_t)l * 1024 + kb) * 6144 + n0 + col;
            const LAS float* scp = sc + kb * 12;
            for (int k0 = 0; k0 < nk; k0 += 16) {
                float wq[16];
#pragma unroll
                for (int u = 0; u < 16; ++u) wq[u] = w[(size_t)(k0 + u) * 6144];
#pragma unroll
                for (int u = 0; u < 16; ++u) { const LAS float* q = scp + (k0 + u) * 12; const f32x4 a = *(const LAS f32x4*)q, b = *(const LAS f32x4*)(q + 4); const float c8 = q[8];
                    acc[0] += a[0] * wq[u]; acc[1] += a[1] * wq[u]; acc[2] += a[2] * wq[u]; acc[3] += a[3] * wq[u];
                    acc[4] += b[0] * wq[u]; acc[5] += b[1] * wq[u]; acc[6] += b[2] * wq[u]; acc[7] += b[3] * wq[u]; acc[8] += c8 * wq[u]; }
            }
#pragma unroll
            for (int ci = 0; ci < 9; ++ci) red[(ks * 9 + ci) * 96 + col] = acc[ci];
        }
        __syncthreads();
        for (int o = tid; o < 9 * 96; o += 512) { const int ci = o / 96, cc = o - ci * 96;
            float sacc = 0.f;
#pragma unroll
            for (int q = 0; q < 5; ++q) sacc += red[(q * 9 + ci) * 96 + cc];
            p.mod[(size_t)(l * 9 + ci) * 6144 + n0 + cc] = sacc + p.b_mod[l * 6144 + n0 + cc]; }
        __syncthreads();
    }
}
__device__ __forceinline__ void cvt_seg(const float* W, bf16_t* WT, int K, int N, int nmat, LAS float* scr, int gw, int ngw, int lane) {
    const int nblk = N / 32, per = (K / 64) * nblk, total = per * nmat;
    int it = gw; if (it >= total) return;
    f32x4 cur[8], nxt[8];
    { const int mi = it / per; cv8_load(W + (size_t)mi * K * N, N, it - mi * per, nblk, lane, cur); }
    for (; it < total; it += ngw) {
        const int itn = (it + ngw < total) ? it + ngw : it;
        { const int mn = itn / per; cv8_load(W + (size_t)mn * K * N, N, itn - mn * per, nblk, lane, nxt); }
        asm volatile("" ::: "memory");
        const int mi = it / per;
        cvb_emit(cur, K, WT + (size_t)mi * K * N, scr, it - mi * per, nblk, lane);
#pragma unroll
        for (int i = 0; i < 8; ++i) cur[i] = nxt[i];
    }
}
__device__ __forceinline__ void cvt8_seg(const float* W, unsigned char* WT, int K, int N, LAS float* scr, int gw, int ngw, int lane, int lo, int total) {
    const int nblk = N / 32, per = (K / 64) * nblk;
    int it = lo + gw; if (it >= total) return;
    f32x4 cur[8], nxt[8];
    { const int mi = it / per; cv8_load(W + (size_t)mi * K * N, N, it - mi * per, nblk, lane, cur); }
    for (; it < total; it += ngw) {
        const int itn = (it + ngw < total) ? it + ngw : it;
        { const int mn = itn / per; cv8_load(W + (size_t)mn * K * N, N, itn - mn * per, nblk, lane, nxt); }
        asm volatile("" ::: "memory");
        const int mi = it / per;
        cv8_emit(cur, K, N, WT + (size_t)mi * K * N, scr, it - mi * per, nblk, lane);
#pragma unroll
        for (int i = 0; i < 8; ++i) cur[i] = nxt[i];
    }
}
__device__ __forceinline__ void cvt_moe_layer(const P& p, int l, LAS float* scr, int gw, int ngw, int lane, int ilo, int ihi) {
    unsigned char* dst = p.wt8 + (size_t)l * 3 * 16 * 1024 * 1024; const size_t lo = (size_t)l * 16 * 1024 * 1024;
    cvt8_seg(p.moe_w_gate + lo, dst, 1024, 1024, scr, gw, ngw, lane, ilo, ihi);
    cvt8_seg(p.moe_w_up + lo, dst + (size_t)16 * 1024 * 1024, 1024, 1024, scr, gw, ngw, lane, ilo, ihi);
    cvt8_seg(p.moe_w_down + lo, dst + (size_t)32 * 1024 * 1024, 1024, 1024, scr, gw, ngw, lane, ilo, ihi);
}
#define IDLE_CVT(nunits, ilo, ihi) do { const Ids Ic = fresh_ids(wv); const int rem_ = (nunits) % Ic.G; if (Ic.bid >= rem_) \
        cvt_moe_layer(p, l, (LAS float*)(lds + Ic.wid * 8704), (Ic.bid - rem_) * 8 + Ic.wid, (Ic.G - rem_) * 8, Ic.lane, (ilo), (ihi)); } while (0)

constexpr int LDS_TAB_OFF = 131072, LDS_MISC_OFF = 147456, LDS_BYTES = LDS_MISC_OFF + 1024;
constexpr int N_PHASES = 2 + 9 * 4;
constexpr int CV_I = 3072, CV_SC = 6144, CV_NX = 3072, CV_SO = 6144;
typedef const __attribute__((address_space(4))) P* KP;
__device__ __forceinline__ KP fresh(KP k) { asm volatile("" : "+s"(k)); return k; }
#if defined(__HIP_DEVICE_COMPILE__)
#define PL const P p = *fresh(kp)
#else
#define PL const P p = p_args
#endif
__global__ void __launch_bounds__(512, 2) k_fwd(P p_args, int ph_lo, int ph_hi) {
    const KP kp = (KP)__builtin_amdgcn_kernarg_segment_ptr(); (void)p_args;
    extern __shared__ __attribute__((aligned(16))) unsigned char lds_raw[];
    LAS unsigned char* lds = (LAS unsigned char*)lds_raw;
    const int tid = threadIdx.x; (void)ph_lo; (void)ph_hi;
    const int wv = __builtin_amdgcn_readfirstlane(tid >> 6);
    volatile LAS unsigned* MISC = (volatile LAS unsigned*)(lds + LDS_MISC_OFF);
    if (tid < 256) MISC[tid] = 0u;
    __syncthreads();
    { PL; const XcdBarrier b0 = xcd_barrier_post(p.bar, MISC + 8); if (tid == 0) MISC[10] = b0.x; }
#define GRID_SYNC() do { XcdBarrier b_; b_.bar = fresh(kp)->bar; b_.x = MISC[10]; b_.st = MISC + 8; xcd_barrier(b_); } while (0)
#if MK_PER_PHASE
#define IN(k) (ph_lo <= (k) && (k) < ph_hi)
#else
#define IN(k) true
#endif
#define SEAM(k) do { if (IN(k) && IN((k) + 1)) { GRID_SYNC(); if (PROBE_KIND == 11) GRID_SYNC(); } } while (0)
#define REPEAT(kind) for (int rep_ = 0; rep_ < ((PROBE_KIND == (kind)) ? 2 : 1); ++rep_)
#define REPBAR(kind) do { if (PROBE_KIND == (kind) && rep_ == 0) GRID_SYNC(); } while (0)

    if (IN(0)) REPEAT(10) {
        PL; mod_phase(p, lds, wv);
        const Ids I = fresh_ids(wv); const int gw = I.gw, ngw = I.ngw, lane = I.lane; LAS float* scr = (LAS float*)(lds + I.wid * 8704);
        cvt_seg(p.lru_w_in, p.wt_lru_in, 1024, 2560, 2, scr, gw, ngw, lane);
        cvt_seg(p.lru_w_out, p.wt_lru_out, 1280, 1024, 2, scr, gw, ngw, lane);
        cvt_seg(p.sg_w_out, p.wt_sg_out, 2048, 1024, 2, scr, gw, ngw, lane);
        cvt_seg(p.lru_w_a, p.wt_a, 128, 128, 40, scr, gw, ngw, lane);
        cvt_seg(p.lru_w_x, p.wt_x, 128, 128, 40, scr, gw, ngw, lane);
        __syncthreads();
        cvt_i8_panels(p.sg_w_in, p.wq_sg_in, p.wsc_sg_in, lds, I.bid, I.G, I.tid);
        REPBAR(10);
    }
    SEAM(0);
    if (IN(1)) REPEAT(7) { PL; rowA_phase(p, 0, wv, PROBE_KIND == 7 && rep_ == 0); REPBAR(7); }
    SEAM(1);
    for (int l = 0; l < 4; ++l) {
        const int jl = l >> 1, b = 2 + 9 * l;
        const size_t wmoe_off = (size_t)l * 3 * 16 * 1024 * 1024;
        if ((l & 1) == 0) {
            if (IN(b + 0)) REPEAT(1) { PL; const Ids I0 = fresh_ids(wv); pg8::Prob<pg8::K_LRU_IN, 1024> pr; pr.A = p.hn; pr.B0 = p.wt_lru_in + (size_t)jl * 2560 * 1024; pr.O0 = p.gate; pr.O1 = p.xpre; pr.S.init(NTOK, 2560, (int)gridDim.x, I0.bid); pr.tab = (LAS unsigned*)(lds + LDS_TAB_OFF); pg8::gemm_phase(lds, pr, wv); IDLE_CVT(1600, 0, CV_I); REPBAR(1); }
            SEAM(b + 0);
            if (IN(b + 1)) REPEAT(4) { PL; LruW W{p.wt_a, p.wt_x}; lru_scan_phase(p, W, jl, lds, wv); IDLE_CVT(NCK * 10, CV_I, CV_SC); REPBAR(4); }
            SEAM(b + 1);
            if (IN(b + 2)) REPEAT(5) { PL; lru_fix_phase(p, jl, wv); REPBAR(5); }
            SEAM(b + 2);
            if (IN(b + 3)) REPEAT(1) { PL; const Ids I0 = fresh_ids(wv); pg8::Prob<pg8::K_OUT, 1280> pr; pr.A = p.zl; pr.B0 = p.wt_lru_out + (size_t)jl * 1024 * 1280; pr.O0 = p.x; pr.gvec = p.mod + (size_t)l * 9 * 6144; pr.S.init(NTOK, 1024, (int)gridDim.x, I0.bid); pr.tab = (LAS unsigned*)(lds + LDS_TAB_OFF); pg8::gemm_phase(lds, pr, wv); IDLE_CVT(640, CV_SC, 8192); REPBAR(1); }
            SEAM(b + 3);
        } else {
            if (IN(b + 0)) REPEAT(1) { PL; const Ids I0 = fresh_ids(wv); pg8::Prob<pg8::K_SG_IN, 1024> pr; pr.A = p.hn8i; pr.B0 = p.wq_sg_in + (size_t)jl * 4096 * 1024; pr.O0 = p.proj; pr.vss = p.vss; pr.gsel = p.hsc; pr.gvec = p.wsc_sg_in + (size_t)jl * 4096; pr.S.init(NTOK, 4096, (int)gridDim.x, I0.bid); pr.tab = (LAS unsigned*)(lds + LDS_TAB_OFF); pg8::gemm_phase(lds, pr, wv); REPBAR(1); }
            SEAM(b + 0);
            if (IN(b + 1)) REPEAT(6) { PL; sgu_phase(p, jl, lds, wv); REPBAR(6); }
            SEAM(b + 1);
#if MK_PER_PHASE
            SEAM(b + 2);
#endif
            if (IN(b + 3)) REPEAT(1) { PL; const Ids I0 = fresh_ids(wv); pg8::Prob<pg8::K_OUT, 2048> pr; pr.A = p.zsg; pr.B0 = p.wt_sg_out + (size_t)jl * 1024 * 2048; pr.O0 = p.x; pr.gvec = p.mod + (size_t)l * 9 * 6144; pr.S.init(NTOK, 1024, (int)gridDim.x, I0.bid); pr.tab = (LAS unsigned*)(lds + LDS_TAB_OFF); pg8::gemm_phase(lds, pr, wv); IDLE_CVT(640, CV_NX, CV_SO); REPBAR(1); }
            SEAM(b + 3);
        }
        if (IN(b + 4)) for (int rep_ = 0; rep_ < ((PROBE_KIND == 8 || PROBE_KIND == 12) ? 2 : 1); ++rep_) { PL; rowB_phase(p, l, lds, wv, (PROBE_KIND == 8 || PROBE_KIND == 12) && rep_ == 0); if ((PROBE_KIND == 8 || PROBE_KIND == 12) && rep_ == 0) GRID_SYNC(); }
        SEAM(b + 4);
        if (IN(b + 5)) for (int rep_ = 0; rep_ < ((PROBE_KIND == 9 || (PROBE_KIND >= 16 && PROBE_KIND <= 17)) ? 2 : 1); ++rep_) {
            PL; const Ids I = fresh_ids(wv); const int bid = I.bid;
            if (bid < 32) { LAS unsigned (*red)[8] = (LAS unsigned (*)[8])lds; const int e = bid & 15;
                const bool xp = (PROBE_KIND >= 16 && PROBE_KIND <= 17 && rep_ == 0); const float* asrc = xp ? p.affT2 : p.affT;
                if (bid < 16) select_body<16>(p, asrc, e, 0, CAP_CTX, 0, red, wv, xp); else select_body<64>(p, asrc, e, NCTX, CAP_SMP, CAP_CTX, red, wv, xp); }
            else if (!(PROBE_KIND >= 16 && PROBE_KIND <= 17 && rep_ == 0)) { if (l & 1) cvt_moe_layer(p, l, (LAS float*)(lds + I.wid * 8704), (bid - 32) * 8 + I.wid, (I.G - 32) * 8, I.lane, CV_SO, 8192); else cvt_moe_layer(p, l + 1, (LAS float*)(lds + I.wid * 8704), (bid - 32) * 8 + I.wid, (I.G - 32) * 8, I.lane, 0, CV_NX); }
            if ((PROBE_KIND == 9 || (PROBE_KIND >= 16 && PROBE_KIND <= 17)) && rep_ == 0) GRID_SYNC();
        }
        SEAM(b + 5);
        if (IN(b + 6)) REPEAT(2) { PL; const Ids I0 = fresh_ids(wv); pg8::Prob<pg8::K_MOE1, 1024> pr; pr.A = p.hn8; pr.B0 = p.wt8 + wmoe_off; pr.B1 = p.wt8 + wmoe_off + (size_t)16 * 1024 * 1024; pr.O0 = p.hh8; pr.idx = p.idx; pr.S.init(NSLOT, 2048, (int)gridDim.x, I0.bid); pr.tab = (LAS unsigned*)(lds + LDS_TAB_OFF); pg8::gemm_phase(lds, pr, wv); REPBAR(2); }
        SEAM(b + 6);
        if (IN(b + 7)) REPEAT(2) { PL; const Ids I0 = fresh_ids(wv); pg8::Prob<pg8::K_MOE2, 1024> pr; pr.A = p.hh8; pr.B0 = p.wt8 + wmoe_off + (size_t)32 * 1024 * 1024; pr.O0 = p.outm; pr.gsel = p.gsel; pr.S.init(NSLOT, 1024, (int)gridDim.x, I0.bid); pr.tab = (LAS unsigned*)(lds + LDS_TAB_OFF); pg8::gemm_phase(lds, pr, wv); REPBAR(2); }
        SEAM(b + 7);
        if (IN(b + 8)) REPEAT(7) { PL; rowA_phase(p, l + 1, wv, PROBE_KIND == 7 && rep_ == 0); REPBAR(7); }
        SEAM(b + 8);
    }
#undef IN
#undef SEAM
}

static inline size_t al(size_t x) { return (x + 255) & ~(size_t)255; }
extern "C" void kernel_launch(void* const* d_in, const int* in_sizes, int n_in, void* d_out, int out_size, void* d_ws, size_t ws_size, hipStream_t stream) {
    P p{};
    const float* const* in = (const float* const*)d_in;
    p.x_prompt = in[0]; p.x_sample = in[1]; p.state_lru = in[2]; p.c = in[3]; p.c_ctx = in[4]; p.norm1_g = in[5]; p.norm2_g = in[6]; p.w_mod = in[7]; p.b_mod = in[8];
    p.lru_w_in = in[9]; p.lru_conv_w = in[10]; p.lru_conv_b = in[11]; p.lru_w_a = in[12]; p.lru_b_a = in[13]; p.lru_w_x = in[14]; p.lru_b_x = in[15]; p.lru_lam = in[16]; p.lru_w_out = in[17];
    p.sg_w_in = in[18]; p.sg_norm_g = in[19]; p.sg_w_s = in[20]; p.sg_b_s = in[21]; p.sg_w_out = in[22];
    p.moe_router = in[23]; p.moe_w_gate = in[24]; p.moe_w_up = in[25]; p.moe_w_down = in[26]; p.final_norm_g = in[27];
    p.xout = (float*)d_out; p.new_state = (float*)d_out + (size_t)NTOK * DM;
    char* w = (char*)d_ws; size_t o = 0;
    auto take = [&](size_t bytes) { char* r = w + o; o += al(bytes); return r; };
    p.bar = (unsigned*)take((size_t)XCD_BAR_WORDS * 4);
    p.mod = (float*)take((size_t)4 * 9 * 6144 * 4);
    p.x = (bf16_t*)take((size_t)NTOK * DM * 2);
    p.hn = (bf16_t*)take((size_t)NTOK * DM * 2);
    const size_t R = (size_t)NTOK * LW * 2;
    char* r1 = take(R); char* r2 = take(R); char* r3 = take(R); char* r4 = take(R); char* r5 = take(R);
    char* r6 = take((size_t)NTOK * SGW * 2 - R);
    (void)r6;
    p.gate = (bf16_t*)r1; p.xpre = (bf16_t*)r2; p.zl = (bf16_t*)r2; p.S = (bf16_t*)r3; p.Af = (unsigned char*)r4; p.Ab = (unsigned char*)r5;
    p.proj = (bf16_t*)r1; p.zsg = (bf16_t*)r5; p.hh8 = (unsigned char*)r1; p.hn8 = (unsigned char*)p.hn; p.hn8i = (signed char*)p.hn; p.outm = (unsigned char*)r3; p.y = (bf16_t*)r3;
    p.agg = (float*)take((size_t)NCK128 * 2 * 2 * LW * 4);
    p.k2tab = (float*)take((size_t)4 * LW * 4);
    p.vss = (float*)take((size_t)NTOK * 32 * 4);
    p.affT = (float*)take((size_t)NE * NTOK * 4);
    p.affT2 = (float*)take((size_t)NE * NTOK * 4);
    p.idx = (int*)take((size_t)NSLOT * 4);
    p.gsel = (float*)take((size_t)NSLOT * 4);
    p.inv = (int*)take((size_t)NE * NTOK * 4);
    p.wt_lru_in = (bf16_t*)take((size_t)2 * 2560 * 1024 * 2); p.wq_lru_in = nullptr; p.wsc_lru_in = nullptr;
    p.wt_lru_out = (bf16_t*)take((size_t)2 * 1024 * 1280 * 2);
    p.wq_sg_in = (signed char*)take((size_t)2 * 4096 * 1024); p.wsc_sg_in = (float*)take((size_t)2 * 4096 * 4); p.wpm_sg_in = (float*)take((size_t)16 * 2 * 4096 * 4);
    p.hsc = (float*)take((size_t)NTOK * 4);
    p.wt_sg_out = (bf16_t*)take((size_t)2 * 1024 * 2048 * 2);
    p.wt_a = (bf16_t*)take((size_t)40 * 128 * 128 * 2);
    p.wt_x = (bf16_t*)take((size_t)40 * 128 * 128 * 2);
    p.wt8 = (unsigned char*)take((size_t)4 * 3 * 16 * 1024 * 1024);
    (void)ws_size; (void)in_sizes; (void)n_in; (void)out_size;

    static int grid = 0;
    if (!grid) {
        int dev = 0, cus = 0;
        (void)hipGetDevice(&dev); (void)hipDeviceGetAttribute(&cus, hipDeviceAttributeMultiprocessorCount, dev);
        (void)hipFuncSetAttribute((const void*)k_fwd, hipFuncAttributeMaxDynamicSharedMemorySize, LDS_BYTES);
        grid = cus > 0 ? cus : 256;
    }
    (void)hipMemsetAsync(p.bar, 0, (size_t)XCD_BAR_WORDS * 4, stream);
#if MK_PER_PHASE
    for (int ph = 0; ph < N_PHASES; ++ph) hipLaunchKernelGGL(k_fwd, dim3(grid), dim3(512), LDS_BYTES, stream, p, ph, ph + 1);
#else
    hipLaunchKernelGGL(k_fwd, dim3(grid), dim3(512), LDS_BYTES, stream, p, 0, N_PHASES);
#endif
}
```

```cpp
#include <hip/hip_runtime.h>
#include <stdint.h>

#ifndef PROBE_KIND
#define PROBE_KIND 0
#endif
#ifndef MK_PER_PHASE
#define MK_PER_PHASE 0
#endif

typedef unsigned short bf16_t;
constexpr int DM = 1024, NCTX = 8192, NSMP = 32768, NTOK = 40960;
constexpr int LW = 1280, SGW = 2048, NE = 16;
constexpr int CAP_CTX = 1024, CAP_SMP = 4096, SLOTS_E = 5120, NSLOT = NE * SLOTS_E;
constexpr int NCK = NTOK / 256;
constexpr float RMS_EPS = 1e-6f;
#define LAS __attribute__((address_space(3)))

__device__ __forceinline__ float bf2f(bf16_t b) { return __uint_as_float(((unsigned)b) << 16); }
__device__ __forceinline__ bf16_t f2bf(float f) { unsigned r; asm("v_cvt_pk_bf16_f32 %0, %1, %1" : "=v"(r) : "v"(f)); return (bf16_t)r; }
__device__ __forceinline__ int tok_cond(int r) { return r < NCTX ? 0 : 1 + ((r - NCTX) >> 12); }
__device__ __forceinline__ float shx(float v, int o, int lane) { return __int_as_float(__builtin_amdgcn_ds_bpermute((lane ^ o) << 2, __float_as_int(v))); }
__device__ __forceinline__ unsigned shxu(unsigned v, int o, int lane) { return (unsigned)__builtin_amdgcn_ds_bpermute((lane ^ o) << 2, (int)v); }
__device__ __forceinline__ unsigned shupu(unsigned v, int o, int lane) { return (unsigned)__builtin_amdgcn_ds_bpermute(((lane - o) & 63) << 2, (int)v); }
__device__ __forceinline__ float wave_sum(float v, int lane) {
#pragma unroll
    for (int o = 32; o >= 1; o >>= 1) v += shx(v, o, lane);
    return v;
}


struct Ids { int tid, lane, wid, bid, G, gw, ngw; };
__device__ __forceinline__ Ids fresh_ids(int wv) {
    Ids d; unsigned ones = ~0u; asm volatile("" : "+s"(ones)); int ln = (int)__builtin_amdgcn_mbcnt_hi(ones, __builtin_amdgcn_mbcnt_lo(ones, 0u)); asm volatile("" : "+v"(ln)); int w = wv; asm volatile("" : "+s"(w)); int b = blockIdx.x; asm volatile("" : "+s"(b));
    d.tid = w * 64 + ln; d.lane = ln; d.wid = w; d.bid = b; d.G = gridDim.x; d.gw = b * 8 + w; d.ngw = d.G * 8; return d;
}

struct P {
    const float *x_prompt, *x_sample, *state_lru, *c, *c_ctx, *norm1_g, *norm2_g, *w_mod, *b_mod;
    const float *lru_w_in, *lru_conv_w, *lru_conv_b, *lru_w_a, *lru_b_a, *lru_w_x, *lru_b_x, *lru_lam, *lru_w_out;
    const float *sg_w_in, *sg_norm_g, *sg_w_s, *sg_b_s, *sg_w_out;
    const float *moe_router, *moe_w_gate, *moe_w_up, *moe_w_down, *final_norm_g;
    bf16_t* x;
    float* xout;
    float* new_state;
    unsigned* bar;
    float* mod;
    bf16_t *hn, *y;
    bf16_t *gate, *xpre, *S, *zl;
    unsigned char *Af, *Ab;
    float* agg;
    float* k2tab;
    bf16_t *proj;
    bf16_t *zsg;
    float* vss;
    float* affT;
    float* affT2;
    int* idx;
    float* gsel;
    int* inv;
    unsigned char* hh8;
    unsigned char* hn8;
    unsigned char* outm;
    bf16_t *wt_lru_in, *wt_lru_out, *wt_sg_out, *wt_a, *wt_x;
    signed char *wq_lru_in, *wq_sg_in;
    float *wsc_lru_in, *wsc_sg_in;
    float* wpm_sg_in;
    signed char* hn8i;
    float* hsc;
    unsigned char* wt8;
};


#define XB_TMO      128
#define XB_XCNT(j)  (256  + 64 * (j))
#define XB_XSUB(j)  (1280 + 64 * (j))
#define XB_XGEN(j)  (2304 + 64 * (j))
#define XB_TOP      3328
#define XB_TOPGEN   3392
#define XCD_BAR_WORDS 3456
#define XB_SPIN_CAP (1u << 18)
__device__ __forceinline__ unsigned xb_ld(unsigned* p)              { return __hip_atomic_load(p, __ATOMIC_RELAXED, __HIP_MEMORY_SCOPE_AGENT); }
__device__ __forceinline__ unsigned xb_add(unsigned* p, unsigned v) { return __hip_atomic_fetch_add(p, v, __ATOMIC_RELAXED, __HIP_MEMORY_SCOPE_AGENT); }
__device__ __forceinline__ unsigned xb_xcc_id() { return (unsigned)__builtin_amdgcn_s_getreg((3 << 11) | 20) & 0xFu; }
#define XB_SPIN(cond, bar) do { unsigned _sp = 0; while (cond) { __builtin_amdgcn_s_sleep(1); \
    if ((++_sp & 255u) == 0u) { if (xb_ld(&(bar)[XB_TMO])) break; if (_sp > XB_SPIN_CAP) { atomicAdd(&(bar)[XB_TMO], 1u); break; } } } } while (0)
struct XcdBarrier { unsigned* bar; unsigned x; volatile LAS unsigned* st; };
__device__ __forceinline__ XcdBarrier xcd_barrier_post(unsigned* bar, volatile LAS unsigned* st) {
    XcdBarrier b; b.bar = bar; b.x = xb_xcc_id(); b.st = st;
    if (threadIdx.x == 0) (void)xb_add(&bar[XB_XCNT(b.x)], 1u);
    return b;
}
__device__ __forceinline__ void xcd_barrier_complete(unsigned* bar, unsigned x, unsigned& nloc, unsigned& nx) {
    const unsigned G = gridDim.x * gridDim.y * gridDim.z;
    unsigned sum, cnt, mine, sp = 0u;
    for (;;) {
        sum = 0u; cnt = 0u; mine = 0u;
#pragma unroll
        for (unsigned j = 0; j < 16; ++j) { const unsigned c = xb_ld(&bar[XB_XCNT(j)]); sum += c; cnt += (c > 0u) ? 1u : 0u; mine = (j == x) ? c : mine; }
        if (sum == G) break;
        __builtin_amdgcn_s_sleep(1);
        if ((++sp & 255u) == 0u) { if (xb_ld(&bar[XB_TMO])) break; if (sp > XB_SPIN_CAP) { atomicAdd(&bar[XB_TMO], 1u); break; } }
    }
    nloc = mine > 0u ? mine : 1u; nx = cnt > 0u ? cnt : 1u;
}
__device__ __forceinline__ void xcd_barrier(const XcdBarrier& b) {
    asm volatile("s_waitcnt vmcnt(0)" ::: "memory");
    __syncthreads();
    if (threadIdx.x == 0) {
        unsigned* bar = b.bar;
        __builtin_amdgcn_s_waitcnt(0);
        unsigned nloc = b.st[0], nx = b.st[1];
        if (nloc == 0u) { xcd_barrier_complete(bar, b.x, nloc, nx); b.st[0] = nloc; b.st[1] = nx; }
        const unsigned old = xb_add(&bar[XB_XSUB(b.x)], 1u);
        const unsigned gen = old / nloc;
        if (old + 1u == (gen + 1u) * nloc) {
            __builtin_amdgcn_fence(__ATOMIC_RELEASE, "agent");
            asm volatile("s_waitcnt vmcnt(0)" ::: "memory");
            const unsigned og = xb_add(&bar[XB_TOP], 1u);
            const unsigned tg = og / nx;
            if (og + 1u == (tg + 1u) * nx) xb_add(&bar[XB_TOPGEN], 1u);
            else XB_SPIN(xb_ld(&bar[XB_TOPGEN]) == tg, bar);
            __builtin_amdgcn_fence(__ATOMIC_ACQUIRE, "agent");
            xb_add(&bar[XB_XGEN(b.x)], 1u);
            asm volatile("s_waitcnt vmcnt(0)" ::: "memory");
        } else {
            XB_SPIN(xb_ld(&bar[XB_XGEN(b.x)]) == gen, bar);
            __builtin_amdgcn_fence(__ATOMIC_ACQUIRE, "agent");
            asm volatile("s_waitcnt vmcnt(0)" ::: "memory");
        }
    }
    __syncthreads();
}

__device__ __forceinline__ void transpose32(unsigned (&A)[32]) {
#pragma unroll
    for (int s = 0; s < 5; ++s) {
        const int j = 16 >> s;
        const unsigned m = (s == 0) ? 0x0000ffffu : (s == 1) ? 0x00ff00ffu : (s == 2) ? 0x0f0f0f0fu : (s == 3) ? 0x33333333u : 0x55555555u;
#pragma unroll
        for (int blk = 0; blk < 32; blk += 2 * j)
#pragma unroll
            for (int i = 0; i < j; ++i) { const int k = blk + i; const unsigned t = ((A[k] >> j) ^ A[k + j]) & m; A[k] ^= t << j; A[k + j] ^= t; }
    }
}
__device__ __forceinline__ unsigned wave_total_u32(unsigned v) {
    v += (unsigned)__builtin_amdgcn_update_dpp(0, (int)v, 0x111, 0xf, 0xf, false);
    v += (unsigned)__builtin_amdgcn_update_dpp(0, (int)v, 0x112, 0xf, 0xf, false);
    v += (unsigned)__builtin_amdgcn_update_dpp(0, (int)v, 0x114, 0xf, 0xf, false);
    v += (unsigned)__builtin_amdgcn_update_dpp(0, (int)v, 0x118, 0xf, 0xf, false);
    return (unsigned)(__builtin_amdgcn_readlane((int)v, 15) + __builtin_amdgcn_readlane((int)v, 31)) + (unsigned)(__builtin_amdgcn_readlane((int)v, 47) + __builtin_amdgcn_readlane((int)v, 63));
}
template <int CNT> __device__ __forceinline__ void select_body(const P& p, const float* affsrc, int e, int base_tok, int cap, int slot_base, LAS unsigned (*red)[8], int wv, int early = 0) {
    const Ids I = fresh_ids(wv); const int tid = I.tid, lane = I.lane, wid = I.wid;
    const float* col = affsrc + (size_t)e * NTOK + base_tok + tid * CNT;
    unsigned key[CNT];
#pragma unroll
    for (int k = 0; k < CNT; k += 4) { const float4 v = *(const float4*)(col + k); key[k] = __float_as_uint(v.x); key[k + 1] = __float_as_uint(v.y); key[k + 2] = __float_as_uint(v.z); key[k + 3] = __float_as_uint(v.w); }
    constexpr int NBLK = (CNT + 31) / 32;
    unsigned pl[NBLK][32], alive[NBLK];
#pragma unroll
    for (int b = 0; b < NBLK; ++b) {
#pragma unroll
        for (int r = 0; r < 32; ++r) pl[b][r] = (b * 32 + r < CNT) ? key[(b * 32 + r < CNT) ? b * 32 + r : 0] : 0u;
        transpose32(pl[b]);
        alive[b] = (CNT - 32 * b >= 32) ? 0xffffffffu : ((1u << ((CNT - 32 * b) & 31)) - 1u);
    }
    unsigned T = 0u, above = 0u, cg = 0u; int pp = 0;
#pragma unroll
    for (int bit = 30; bit >= 0; --bit) {
        unsigned m[NBLK], c = 0u;
#pragma unroll
        for (int b = 0; b < NBLK; ++b) { m[b] = alive[b] & pl[b][bit]; c += (unsigned)__builtin_popcount(m[b]); }
        const unsigned wsum = wave_total_u32(c);
        if (lane == 0) red[pp][wid] = wsum;
        __syncthreads();
        unsigned part = 0;
#pragma unroll
        for (int w = 0; w < 8; ++w) part += red[pp][w];
        const bool take = above + part >= (unsigned)cap;
        if (take) T |= 1u << bit; else { above += part; cg += c; }
#pragma unroll
        for (int b = 0; b < NBLK; ++b) alive[b] = take ? m[b] : (alive[b] ^ m[b]);
        pp ^= 1;
    }
    if (PROBE_KIND == 17 && early) { if (tid == 0) p.affT2[(size_t)e * NTOK + base_tok] = __uint_as_float(T); return; }
    unsigned ceq = 0u;
#pragma unroll
    for (int b = 0; b < NBLK; ++b) ceq += (unsigned)__builtin_popcount(alive[b]);
    unsigned pg = cg, pe = ceq;
#pragma unroll
    for (int o = 1; o < 64; o <<= 1) { const unsigned a = shupu(pg, o, lane), b = shupu(pe, o, lane); if (lane >= o) { pg += a; pe += b; } }
    __syncthreads();
    if (lane == 63) { red[0][wid] = pg; red[1][wid] = pe; }
    __syncthreads();
    unsigned offg = 0, offe = 0, totg = 0;
#pragma unroll
    for (int w = 0; w < 8; ++w) { if (w < wid) { offg += red[0][w]; offe += red[1][w]; } totg += red[0][w]; }
    const unsigned need = (unsigned)cap - totg;
    unsigned eg = offg + pg - cg;
    unsigned ee = offe + pe - ceq;
    constexpr int N = CNT * 512, ISTR = CNT + 2;
    LAS short* invS = (LAS short*)((LAS unsigned char*)red + 256);
    LAS int* idxS = (LAS int*)((LAS unsigned char*)invS + 512 * ISTR * 2);
    LAS unsigned* gS = (LAS unsigned*)(idxS + CNT * 64);
#pragma unroll
    for (int k = 0; k < CNT; ++k) {
        const bool gt = key[k] > T, eq = key[k] == T;
        const bool sel = gt || (eq && ee < need);
        int pos = -1;
        if (sel) { pos = (int)(eg + (ee < need ? ee : need)); idxS[pos] = base_tok + tid * CNT + k; gS[pos] = key[k]; }
        eg += gt ? 1u : 0u; ee += eq ? 1u : 0u;
        invS[tid * ISTR + k] = (short)pos;
    }
    __syncthreads();
    const int sbase = e * SLOTS_E + slot_base;
    int* invg = p.inv + (size_t)e * NTOK + base_tok;
    for (int i = tid; i < N; i += 512) { const int t = i / CNT, k = i - t * CNT; const int v = invS[t * ISTR + k]; invg[i] = v < 0 ? -1 : sbase + v; }
    for (int i = tid; i < CNT * 64; i += 512) { p.idx[sbase + i] = idxS[i]; p.gsel[sbase + i] = __uint_as_float(gS[i]); }
}

typedef short bf16x8 __attribute__((ext_vector_type(8)));
typedef float f32x4 __attribute__((ext_vector_type(4)));
typedef float f32x2 __attribute__((ext_vector_type(2)));
typedef unsigned u32x4 __attribute__((ext_vector_type(4)));
typedef unsigned u32x2 __attribute__((ext_vector_type(2)));
__device__ __forceinline__ float h2f(unsigned h) { return (float)__builtin_bit_cast(_Float16, (unsigned short)h); }
__device__ __forceinline__ unsigned f2h(float f) { return (unsigned)__builtin_bit_cast(unsigned short, (_Float16)f); }
__device__ __forceinline__ float4 xs_unpack(u32x2 w) { return make_float4(h2f(w[0] & 0xffffu), h2f(w[0] >> 16), h2f(w[1] & 0xffffu), h2f(w[1] >> 16)); }
__device__ __forceinline__ u32x2 xs_pack(float4 v) { u32x2 o; o[0] = f2h(v.x) | (f2h(v.y) << 16); o[1] = f2h(v.z) | (f2h(v.w) << 16); return o; }

namespace pg8 {
constexpr int BM = 256, BK = 64, HALF = 128, HTB = HALF * BK * 2, STAGE_BYTES = 8 * HTB, NXCD = 8, WGM = 8;
__host__ __device__ __forceinline__ int lds_byte(int r, int c) { const int st = (r >> 4) * 2 + (c >> 5), rr = r & 15, cc = c & 31, ob = rr * 64 + cc * 2; return st * 1024 + (ob ^ (((ob >> 9) & 1) << 5)); }
__host__ __device__ __forceinline__ void stage_rc(int b, int& R, int& C) { const int st = b / 1024, sb = b % 1024, swz = sb ^ (((sb >> 9) & 1) << 5); R = (st >> 1) * 16 + swz / 64; C = (st & 1) * 32 + (swz % 64) / 2; }
__host__ __device__ __forceinline__ int perm32(int rho) { const int n = rho >> 4, i = rho & 15; return 8 * (i >> 2) + 4 * n + (i & 3); }
struct Unit { int pm, pn; };
struct StaticOrder {
    int nM, nN, nwg, G, c;
    __host__ __device__ void init(int M, int N, int G_, int c_) { nM = M / BM; nN = N / BM; nwg = nM * nN; G = G_; c = c_; }
    __host__ __device__ bool next(int i, Unit& u) const {
        const long L = (long)i * G + c; if (L >= nwg) return false;
        int wgid = (int)L; { const int q = nwg / NXCD, r = nwg % NXCD, xcd = wgid % NXCD, off = wgid / NXCD; wgid = (xcd < r ? xcd * (q + 1) : r * (q + 1) + (xcd - r) * q) + off; }
        const int nig = WGM * nN, gid = wgid / nig, fm = gid * WGM, gsz = (nM % WGM == 0) ? WGM : ((nM - fm) < WGM ? (nM - fm) : WGM);
        u.pm = fm + ((wgid % nig) % gsz); u.pn = (wgid % nig) / gsz; return true;
    }
};
__device__ __forceinline__ unsigned cvt_pk_bf16(float lo, float hi) { unsigned r; asm volatile("v_cvt_pk_bf16_f32 %0, %1, %2" : "=v"(r) : "v"(lo), "v"(hi)); return r; }
__device__ __forceinline__ float fast_sigmoid(float x) { return __builtin_amdgcn_rcpf(1.0f + __builtin_amdgcn_exp2f(-1.44269504089f * x)); }
__device__ __forceinline__ f32x4 gelu_fast4(f32x4 x) {
    const float c0 = -1.44269504089f * 1.5957691216057308f, c1 = c0 * 0.044715f;
    f32x2 a; a[0] = x[0]; a[1] = x[1]; f32x2 b; b[0] = x[2]; b[1] = x[3];
    f32x2 ta = __builtin_elementwise_fma(a * a, (f32x2){c1, c1}, (f32x2){c0, c0}) * a, tb = __builtin_elementwise_fma(b * b, (f32x2){c1, c1}, (f32x2){c0, c0}) * b;
    f32x2 da, db; da[0] = __builtin_amdgcn_exp2f(ta[0]); da[1] = __builtin_amdgcn_exp2f(ta[1]); db[0] = __builtin_amdgcn_exp2f(tb[0]); db[1] = __builtin_amdgcn_exp2f(tb[1]);
    da = da + 1.0f; db = db + 1.0f;
    f32x2 ra, rb; ra[0] = __builtin_amdgcn_rcpf(da[0]); ra[1] = __builtin_amdgcn_rcpf(da[1]); rb[0] = __builtin_amdgcn_rcpf(db[0]); rb[1] = __builtin_amdgcn_rcpf(db[1]);
    ra = ra * a; rb = rb * b;
    f32x4 o; o[0] = ra[0]; o[1] = ra[1]; o[2] = rb[0]; o[3] = rb[1]; return o;
}
__device__ __forceinline__ f32x4 silu_mul4(f32x4 g, f32x4 u) {
    f32x2 a; a[0] = g[0]; a[1] = g[1]; f32x2 b; b[0] = g[2]; b[1] = g[3]; f32x2 ua; ua[0] = u[0]; ua[1] = u[1]; f32x2 ub; ub[0] = u[2]; ub[1] = u[3];
    const f32x2 za = a * -1.44269504089f, zb = b * -1.44269504089f;
    f32x2 da, db; da[0] = __builtin_amdgcn_exp2f(za[0]); da[1] = __builtin_amdgcn_exp2f(za[1]); db[0] = __builtin_amdgcn_exp2f(zb[0]); db[1] = __builtin_amdgcn_exp2f(zb[1]);
    da = da + 1.0f; db = db + 1.0f;
    f32x2 ra, rb; ra[0] = __builtin_amdgcn_rcpf(da[0]); ra[1] = __builtin_amdgcn_rcpf(da[1]); rb[0] = __builtin_amdgcn_rcpf(db[0]); rb[1] = __builtin_amdgcn_rcpf(db[1]);
    ra = (a * ra) * ua; rb = (b * rb) * ub;
    f32x4 o; o[0] = ra[0]; o[1] = ra[1]; o[2] = rb[0]; o[3] = rb[1]; return o;
}
__device__ __forceinline__ float gelu_fast(float x) { const float u2 = 1.5957691216057308f * (x + 0.044715f * x * x * x); return x * fast_sigmoid(u2); }

enum Kind { K_LRU_IN = 0, K_SG_IN = 1, K_OUT = 2, K_MOE1 = 3, K_MOE2 = 4 };
typedef int i32x8 __attribute__((ext_vector_type(8)));
typedef int i32x4 __attribute__((ext_vector_type(4)));
__device__ __forceinline__ unsigned pack4_fp8(float a, float b, float c, float d) { int v = 0; v = __builtin_amdgcn_cvt_pk_fp8_f32(a, b, v, false); v = __builtin_amdgcn_cvt_pk_fp8_f32(c, d, v, true); return (unsigned)v; }
template <int KIND, int KK> struct Prob {
    static constexpr int K = KK;
    static constexpr bool FP8 = (KIND == K_MOE1 || KIND == K_MOE2);
    static constexpr bool I8 = (KIND == K_SG_IN);
    static constexpr int ROWB = (FP8 || I8) ? KK : 2 * KK;
    static constexpr bool GATHER = (KIND == K_MOE1);
    const void* A; const void* B0; const void* B1;
    void* O0; bf16_t* O1; float* vss; const int* idx; const float* gsel; const float* gvec;
    StaticOrder S;
    LAS unsigned* tab;
    __device__ __forceinline__ bool next(int i, Unit& u) const { return S.next(i, u); }
    __device__ __forceinline__ void prep(int tid) const {
        if constexpr (KIND == K_MOE1 || KIND == K_MOE2 || I8) {
            const int r = tid & 255, par = tid >> 8;
            for (int i0 = 0; ; i0 += 16) {
                unsigned v[8]; bool ok[8];
#pragma unroll
                for (int j = 0; j < 8; ++j) { Unit u; ok[j] = S.next(i0 + 2 * j + par, u); const int src = ok[j] ? u.pm * 256 + r : 0;
                    if constexpr (KIND == K_MOE1) v[j] = (unsigned)idx[src] * (unsigned)ROWB; else v[j] = __float_as_uint(gsel[src]); }
#pragma unroll
                for (int j = 0; j < 8; ++j) if (ok[j]) tab[(i0 + 2 * j + par) * 256 + r] = v[j];
                Unit u2; if (!S.next(i0 + 16, u2)) break;
            }
            __syncthreads();
        }
    }
    __device__ __forceinline__ void a_off(const Unit& u, int ui, const int (&R)[2], const int (&C)[2], unsigned (&off)[2][2]) const {
#pragma unroll
        for (int h = 0; h < 2; ++h)
#pragma unroll
            for (int i = 0; i < 2; ++i) {
                if constexpr (KIND == K_MOE1) off[h][i] = tab[ui * 256 + h * 128 + R[i]] + (unsigned)(C[i] * 2);
                else off[h][i] = (unsigned)(u.pm * 256 + h * 128 + R[i]) * (unsigned)ROWB + (unsigned)(C[i] * 2);
            }
    }
    __device__ __forceinline__ const char* b_half(const Unit& u, int h) const {
        if constexpr (KIND == K_MOE1) { const int e = u.pm / 20; return (const char*)(h ? B1 : B0) + ((size_t)e * 1024 + (size_t)u.pn * 128) * ROWB; }
        else if constexpr (KIND == K_MOE2) { const int e = u.pm / 20; return (const char*)B0 + ((size_t)e * 1024 + (size_t)u.pn * 256 + h * 128) * ROWB; }
        else return (const char*)B0 + ((size_t)u.pn * 256 + h * 128) * ROWB;
    }
    __device__ __forceinline__ void epi(const f32x4 (&acc)[2][2][4][2], const Unit& u, int ui, int wr, int wc, int fr, int fq) const {
        const int rloc0 = wr * 64 + fr, lane = fq * 16 + fr;
        const int cl = wc * 32 + 8 * fq;
        if constexpr (KIND == K_OUT) {
            const int ci = tok_cond(u.pm * 256);
            const float* g1p = gvec + (size_t)ci * 6144 + 2048 + u.pn * 256 + cl;
            f32x4 g[2][2];
#pragma unroll
            for (int bj = 0; bj < 2; ++bj) { g[bj][0] = *(const f32x4*)(g1p + bj * 128); g[bj][1] = *(const f32x4*)(g1p + bj * 128 + 4); }
            bf16_t* xb = (bf16_t*)O0 + (size_t)(u.pm * 256 + rloc0) * 1024 + u.pn * 256 + cl;
#pragma unroll
            for (int ai = 0; ai < 2; ++ai) {
                u32x4 xq[4][2];
#pragma unroll
                for (int m = 0; m < 4; ++m)
#pragma unroll
                    for (int bj = 0; bj < 2; ++bj) xq[m][bj] = *(const u32x4*)(xb + (size_t)(ai * 128 + m * 16) * 1024 + bj * 128);
                asm volatile("" : "+v"(xq[0][0]), "+v"(xq[0][1]), "+v"(xq[1][0]), "+v"(xq[1][1]), "+v"(xq[2][0]), "+v"(xq[2][1]), "+v"(xq[3][0]), "+v"(xq[3][1]) :: "memory");
#pragma unroll
                for (int m = 0; m < 4; ++m)
#pragma unroll
                    for (int bj = 0; bj < 2; ++bj) { const u32x4 w = xq[m][bj]; const f32x4 a0 = acc[ai][bj][m][0], a1 = acc[ai][bj][m][1]; u32x4 o;
                        o.x = f2h(h2f(w.x & 0xffffu) + g[bj][0][0] * a0[0]) | (f2h(h2f(w.x >> 16) + g[bj][0][1] * a0[1]) << 16);
                        o.y = f2h(h2f(w.y & 0xffffu) + g[bj][0][2] * a0[2]) | (f2h(h2f(w.y >> 16) + g[bj][0][3] * a0[3]) << 16);
                        o.z = f2h(h2f(w.z & 0xffffu) + g[bj][1][0] * a1[0]) | (f2h(h2f(w.z >> 16) + g[bj][1][1] * a1[1]) << 16);
                        o.w = f2h(h2f(w.w & 0xffffu) + g[bj][1][2] * a1[2]) | (f2h(h2f(w.w >> 16) + g[bj][1][3] * a1[3]) << 16);
                        *(u32x4*)(xb + (size_t)(ai * 128 + m * 16) * 1024 + bj * 128) = o; }
            }
        } else if constexpr (KIND == K_MOE1) {
#pragma unroll
            for (int ai = 0; ai < 2; ++ai)
#pragma unroll
                for (int m = 0; m < 4; ++m) {
                    const int row = u.pm * 256 + rloc0 + ai * 128 + m * 16;
                    const f32x4 g0 = acc[ai][0][m][0], g1 = acc[ai][0][m][1], u0 = acc[ai][1][m][0], u1 = acc[ai][1][m][1];
                    float o[8];
#pragma unroll
                    for (int j = 0; j < 1; ++j) { const f32x4 s0 = silu_mul4(g0, u0), s1 = silu_mul4(g1, u1); o[0] = s0[0]; o[1] = s0[1]; o[2] = s0[2]; o[3] = s0[3]; o[4] = s1[0]; o[5] = s1[1]; o[6] = s1[2]; o[7] = s1[3]; }
                    u32x2 w; w.x = pack4_fp8(o[0], o[1], o[2], o[3]); w.y = pack4_fp8(o[4], o[5], o[6], o[7]);
                    *(u32x2*)((unsigned char*)O0 + (size_t)row * 1024 + u.pn * 128 + cl) = w;
                }
        } else {
            f32x4 csc[2][2];
            if constexpr (I8) {
#pragma unroll
                for (int bj = 0; bj < 2; ++bj) { const float* wp = gvec + u.pn * 256 + bj * 128 + cl; csc[bj][0] = *(const f32x4*)wp; csc[bj][1] = *(const f32x4*)(wp + 4); }
            }
#pragma unroll
            for (int ai = 0; ai < 2; ++ai)
#pragma unroll
                for (int m = 0; m < 4; ++m) {
                    const int rl = rloc0 + ai * 128 + m * 16, row = u.pm * 256 + rl;
                    float gs = 1.0f; if constexpr (KIND == K_MOE2 || I8) gs = __uint_as_float(tab[ui * 256 + rl]);
                    float ssq = 0.f;
#pragma unroll
                    for (int bj = 0; bj < 2; ++bj) {
                        f32x4 v0 = acc[ai][bj][m][0], v1 = acc[ai][bj][m][1];
                        if constexpr (I8) {
                            const f32x4 s0 = csc[bj][0], s1 = csc[bj][1];
#pragma unroll
                            for (int j = 0; j < 4; ++j) { v0[j] = (float)__float_as_int(v0[j]) * (gs * s0[j]); v1[j] = (float)__float_as_int(v1[j]) * (gs * s1[j]); }
                        }
                        bf16_t* dst;
                        if constexpr (KIND == K_LRU_IN) {
                            if (u.pn < 5) {
#pragma unroll
                                for (int j = 0; j < 1; ++j) { v0 = gelu_fast4(v0); v1 = gelu_fast4(v1); }
                                dst = (bf16_t*)O0 + (size_t)row * 1280 + u.pn * 256 + bj * 128 + cl;
                            } else dst = O1 + (size_t)row * 1280 + (u.pn - 5) * 256 + bj * 128 + cl;
                        } else if constexpr (KIND == K_SG_IN) {
#pragma unroll
                            for (int j = 0; j < 1; ++j) { v0 = gelu_fast4(v0); v1 = gelu_fast4(v1); const f32x4 sq = v0 * v0 + v1 * v1; ssq += (sq[0] + sq[1]) + (sq[2] + sq[3]); }
                            dst = (bf16_t*)O0 + (size_t)row * 4096 + u.pn * 256 + bj * 128 + cl;
                        } else if constexpr (KIND == K_MOE2) {
                            v0 = v0 * (gs * 16.0f); v1 = v1 * (gs * 16.0f);
                            u32x2 w8; w8.x = pack4_fp8(v0[0], v0[1], v0[2], v0[3]); w8.y = pack4_fp8(v1[0], v1[1], v1[2], v1[3]);
                            *(u32x2*)((unsigned char*)O0 + (size_t)row * 1024 + u.pn * 256 + bj * 128 + cl) = w8;
                            continue;
                        } else dst = (bf16_t*)O0 + (size_t)row * 1024 + u.pn * 256 + bj * 128 + cl;
                        u32x4 w; w.x = cvt_pk_bf16(v0[0], v0[1]); w.y = cvt_pk_bf16(v0[2], v0[3]); w.z = cvt_pk_bf16(v1[0], v1[1]); w.w = cvt_pk_bf16(v1[2], v1[3]);
                        *(u32x4*)dst = w;
                    }
                    if constexpr (KIND == K_SG_IN) {
                        if (u.pn >= 8) { ssq += shx(ssq, 16, lane); ssq += shx(ssq, 32, lane); if (fq == 0) vss[(size_t)row * 32 + (u.pn - 8) * 4 + wc] = ssq; }
                    }
                }
        }
    }
};

template <class Pr>
__device__ __forceinline__ void gemm_phase(LAS unsigned char* lds, const Pr& pr, int wv) {
    constexpr int ROWB = Pr::ROWB, nt = ROWB / (BK * 2); constexpr bool FP8 = Pr::FP8;
    const Ids I = fresh_ids(wv); const int tid = I.tid, wid = I.wid, lane = I.lane, wr = wid >> 2, wc = wid & 3, fr = lane & 15, fq = lane >> 4;
    int R[2], C[2]; unsigned voffB[2];
#pragma unroll
    for (int i = 0; i < 2; ++i) { stage_rc(tid * 16 + i * 8192, R[i], C[i]); const int Rb = (R[i] & ~31) + perm32(R[i] & 31); voffB[i] = (unsigned)Rb * (unsigned)ROWB + (unsigned)(C[i] * 2); }
    const unsigned ldsw = (unsigned)wid * 1024u;
    const int aoff = lds_byte(wr * 64 + fr, fq * 8), boff = lds_byte(wc * 32 + fr, fq * 8);
#define PG8_SA(b, h) (((b) * 2 + (h)) * HTB)
#define PG8_SB(b, h) ((4 + (b) * 2 + (h)) * HTB)
#define PG8_STAGE(bufoff, gbase, voff) do { LAS unsigned char* lb_ = lds + ldsw; asm volatile("" : "+s"(lb_));     \
        _Pragma("unroll") for (int _i = 0; _i < 2; ++_i) \
        __builtin_amdgcn_global_load_lds((const unsigned*)((const char*)(gbase) + (voff)[_i]), (LAS unsigned*)(lb_ + (bufoff) + _i * 8192), 16, 0, 0); } while (0)
#define PG8_LD8(off_) ({ const i32x4 lo_ = *(const LAS i32x4*)(lds + (off_)); const i32x4 hi_ = *(const LAS i32x4*)(lds + (off_) + 1024); __builtin_shufflevector(lo_, hi_, 0, 1, 2, 3, 4, 5, 6, 7); })
#define PG8_LDA8(dst, b, h) do { _Pragma("unroll") for (int m = 0; m < 4; ++m) dst[m] = PG8_LD8(PG8_SA(b, h) + aoff + m * 2048); } while (0)
#define PG8_LDB8(dst, b, h) do { _Pragma("unroll") for (int n = 0; n < 2; ++n) dst[n] = PG8_LD8(PG8_SB(b, h) + boff + n * 2048); } while (0)
#define PG8_MMA8(ai, bj, At, Bt) do { __builtin_amdgcn_s_setprio(1); _Pragma("unroll") for (int m = 0; m < 4; ++m) _Pragma("unroll") for (int n = 0; n < 2; ++n) \
        asm volatile("v_mfma_scale_f32_16x16x128_f8f6f4 %0, %1, %2, %0, %3, %4 op_sel_hi:[0,0,0]" : "+v"(acc[ai][bj][m][n]) : "v"(Bt[n]), "v"(At[m]), "v"(sclW), "v"(sclX)); __builtin_amdgcn_s_setprio(0); } while (0)
#define PG8_LDA(dst, b, h) do { _Pragma("unroll") for (int m = 0; m < 4; ++m) _Pragma("unroll") for (int k = 0; k < 2; ++k) dst[m][k] = *(const LAS bf16x8*)(lds + PG8_SA(b, h) + aoff + m * 2048 + k * 1024); } while (0)
#define PG8_LDB(dst, b, h) do { _Pragma("unroll") for (int n = 0; n < 2; ++n) _Pragma("unroll") for (int k = 0; k < 2; ++k) dst[n][k] = *(const LAS bf16x8*)(lds + PG8_SB(b, h) + boff + n * 2048 + k * 1024); } while (0)
#define PG8_MMA(ai, bj, At, Bt) do { __builtin_amdgcn_s_setprio(1); _Pragma("unroll") for (int m = 0; m < 4; ++m) _Pragma("unroll") for (int n = 0; n < 2; ++n) _Pragma("unroll") for (int k = 0; k < 2; ++k) \
        acc[ai][bj][m][n] = __builtin_amdgcn_mfma_f32_16x16x32_bf16(Bt[n][k], At[m][k], acc[ai][bj][m][n], 0, 0, 0); __builtin_amdgcn_s_setprio(0); } while (0)
#define PG8_WAIT_V(n) asm volatile("s_waitcnt vmcnt(" #n ")" ::: "memory")
#define PG8_WAIT_L(n) asm volatile("s_waitcnt lgkmcnt(" #n ")" ::: "memory")
#define PG8_BAR __builtin_amdgcn_s_barrier()
#define PG8_SCHED __builtin_amdgcn_sched_barrier(0)
    pr.prep(tid);
    Unit cur, nxt; int ui = 0;
    if (!pr.next(0, cur)) return;
    f32x4 acc[2][2][4][2];
#pragma unroll
    for (int a = 0; a < 2; ++a)
#pragma unroll
        for (int b = 0; b < 2; ++b)
#pragma unroll
            for (int m = 0; m < 4; ++m)
#pragma unroll
                for (int n = 0; n < 2; ++n) acc[a][b][m][n] = (f32x4){0.f, 0.f, 0.f, 0.f};
    bf16x8 At[4][2], B0[2][2], B1[2][2]; i32x8 At8[4], B08[2], B18[2];
    const int sclW = 0x7a7a7a7a, sclX = 0x7f7f7f7f;
#define PG8_XLDA(b, h) do { if constexpr (FP8) PG8_LDA8(At8, b, h); else PG8_LDA(At, b, h); } while (0)
#define PG8_XLDB0(b, h) do { if constexpr (FP8) PG8_LDB8(B08, b, h); else PG8_LDB(B0, b, h); } while (0)
#define PG8_XLDB1(b, h) do { if constexpr (FP8) PG8_LDB8(B18, b, h); else PG8_LDB(B1, b, h); } while (0)
#define PG8_MMAI(ai, bj, At, Bt) do { __builtin_amdgcn_s_setprio(1); _Pragma("unroll") for (int m = 0; m < 4; ++m) _Pragma("unroll") for (int n = 0; n < 2; ++n) _Pragma("unroll") for (int k = 0; k < 2; ++k) \
        asm volatile("v_mfma_i32_16x16x64_i8 %0, %1, %2, %0" : "+v"(acc[ai][bj][m][n]) : "v"(Bt[n][k]), "v"(At[m][k])); __builtin_amdgcn_s_setprio(0); } while (0)
#define PG8_XMMA0(ai, bj) do { if constexpr (FP8) PG8_MMA8(ai, bj, At8, B08); else if constexpr (Pr::I8) PG8_MMAI(ai, bj, At, B0); else PG8_MMA(ai, bj, At, B0); } while (0)
#define PG8_XMMA1(ai, bj) do { if constexpr (FP8) PG8_MMA8(ai, bj, At8, B18); else if constexpr (Pr::I8) PG8_MMAI(ai, bj, At, B1); else PG8_MMA(ai, bj, At, B1); } while (0)
    const char* const Ab = (const char*)pr.A;
    unsigned cA[2][2], nA[2][2];
    pr.a_off(cur, 0, R, C, cA);
    const char* cB0 = pr.b_half(cur, 0); const char* cB1 = pr.b_half(cur, 1);
    constexpr unsigned kstep = BK * 2;
    PG8_STAGE(PG8_SB(0, 0), cB0, voffB); PG8_STAGE(PG8_SB(0, 1), cB1, voffB); PG8_STAGE(PG8_SA(0, 0), Ab, cA[0]); PG8_STAGE(PG8_SA(0, 1), Ab, cA[1]);
    if (wr == 1) PG8_BAR;
    PG8_WAIT_V(2); PG8_BAR;
    PG8_STAGE(PG8_SB(1, 0), cB0 + kstep, voffB); PG8_STAGE(PG8_SA(1, 0), Ab + kstep, cA[0]); PG8_STAGE(PG8_SB(1, 1), cB1 + kstep, voffB);
    PG8_WAIT_V(6); PG8_BAR;
    for (;;) {
        const bool has_next = pr.next(ui + 1, nxt);
        const char* nB0 = cB0; const char* nB1 = cB1;
        unsigned dA = 0u;
        if (has_next) { nB0 = pr.b_half(nxt, 0); nB1 = pr.b_half(nxt, 1);
            if constexpr (Pr::GATHER) pr.a_off(nxt, ui + 1, R, C, nA); else dA = (unsigned)((nxt.pm - cur.pm) * 256) * (unsigned)ROWB; }
        else if constexpr (Pr::GATHER) {
#pragma unroll
            for (int h = 0; h < 2; ++h)
#pragma unroll
                for (int i = 0; i < 2; ++i) nA[h][i] = cA[h][i];
        }
#pragma unroll 1
        for (int t = 0; t < nt; t += 2) {
            const bool last = (t == nt - 2);
            const unsigned k1 = (unsigned)(t + 1) * kstep, k2 = last ? 0u : (unsigned)(t + 2) * kstep, k3 = k2 + kstep;
            unsigned s2[2][2];
#pragma unroll
            for (int h = 0; h < 2; ++h)
#pragma unroll
                for (int i = 0; i < 2; ++i) { if constexpr (Pr::GATHER) s2[h][i] = last ? nA[h][i] : cA[h][i]; else s2[h][i] = cA[h][i] + (last ? dA : 0u); }
            const char* b20 = (last ? nB0 : cB0) + k2; const char* b21 = (last ? nB1 : cB1) + k2;
            PG8_XLDB0(0, 0); PG8_XLDB1(0, 1); PG8_SCHED; PG8_XLDA(0, 0); PG8_STAGE(PG8_SA(1, 1), Ab + k1, cA[1]);
            PG8_WAIT_V(8); PG8_WAIT_L(0); PG8_BAR; PG8_XMMA0(0, 0); PG8_XMMA1(0, 1); PG8_BAR; PG8_SCHED;
            PG8_XLDA(0, 1); PG8_STAGE(PG8_SB(0, 0), b20, voffB); PG8_STAGE(PG8_SB(0, 1), b21, voffB); PG8_STAGE(PG8_SA(0, 0), Ab + k2, s2[0]);
            PG8_WAIT_V(8); PG8_WAIT_L(0); PG8_BAR; PG8_XMMA0(1, 0); PG8_XMMA1(1, 1); PG8_BAR; PG8_SCHED;
            PG8_XLDB0(1, 0); PG8_XLDB1(1, 1); PG8_SCHED; PG8_XLDA(1, 0); PG8_STAGE(PG8_SA(0, 1), Ab + k2, s2[1]);
            PG8_WAIT_V(8); PG8_WAIT_L(0); PG8_BAR; PG8_XMMA0(0, 0); PG8_XMMA1(0, 1); PG8_BAR; PG8_SCHED;
            PG8_XLDA(1, 1); PG8_STAGE(PG8_SB(1, 0), b20 + kstep, voffB); PG8_STAGE(PG8_SB(1, 1), b21 + kstep, voffB); PG8_STAGE(PG8_SA(1, 0), Ab + k3, s2[0]);
            PG8_WAIT_V(8); PG8_WAIT_L(0); PG8_BAR; PG8_XMMA0(1, 0); PG8_XMMA1(1, 1); PG8_BAR; PG8_SCHED;
        }
        if (wr == 0) PG8_BAR;
        pr.epi(acc, cur, ui, wr, wc, fr, fq);
        if (!has_next) break;
#pragma unroll
        for (int a = 0; a < 2; ++a)
#pragma unroll
            for (int b = 0; b < 2; ++b)
#pragma unroll
                for (int m = 0; m < 4; ++m)
#pragma unroll
                    for (int n = 0; n < 2; ++n) acc[a][b][m][n] = (f32x4){0.f, 0.f, 0.f, 0.f};
        cur = nxt; cB0 = nB0; cB1 = nB1; ++ui;
#pragma unroll
        for (int h = 0; h < 2; ++h)
#pragma unroll
            for (int i = 0; i < 2; ++i) { if constexpr (Pr::GATHER) cA[h][i] = nA[h][i]; else cA[h][i] += dA; }
        if (wr == 1) PG8_BAR;
    }
    PG8_WAIT_V(0);
    PG8_BAR;
#undef PG8_SA
#undef PG8_SB
#undef PG8_STAGE
#undef PG8_LDA
#undef PG8_LD8
#undef PG8_LDA8
#undef PG8_LDB8
#undef PG8_MMA8
#undef PG8_XLDA
#undef PG8_XLDB0
#undef PG8_XLDB1
#undef PG8_XMMA0
#undef PG8_MMAI
#undef PG8_XMMA1
#undef PG8_LDB
#undef PG8_MMA
#undef PG8_WAIT_V
#undef PG8_WAIT_L
#undef PG8_BAR
#undef PG8_SCHED
}
}


__device__ __forceinline__ unsigned pk2(float lo, float hi) { unsigned r; asm("v_cvt_pk_bf16_f32 %0, %1, %2" : "=v"(r) : "v"(lo), "v"(hi)); return r; }
__device__ __forceinline__ void transpose_item(const float* W, int K, int N, bf16_t* WT, LAS float* scr, int item, int lane) {
    const int nblk = N / 32, kb = item / nblk, nb = item % nblk, k0 = 64 * kb, n0 = 32 * nb;
#pragma unroll 8
    for (int i = 0; i < 32; ++i) { const int kk = 2 * i + (lane >> 5); scr[kk * 33 + (lane & 31)] = W[(size_t)(k0 + kk) * N + n0 + (lane & 31)]; }
    asm volatile("s_waitcnt lgkmcnt(0)" ::: "memory");
    const int c = lane & 7;
#pragma unroll
    for (int j = 0; j < 4; ++j) { const int n = (lane >> 3) + 8 * j; const LAS float* s = scr + (8 * c) * 33 + n;
        u32x4 o; o.x = pk2(s[0 * 33], s[1 * 33]); o.y = pk2(s[2 * 33], s[3 * 33]); o.z = pk2(s[4 * 33], s[5 * 33]); o.w = pk2(s[6 * 33], s[7 * 33]);
        *(u32x4*)(WT + (size_t)(n0 + n) * K + k0 + 8 * c) = o; }
    asm volatile("s_waitcnt lgkmcnt(0)" ::: "memory");
}

__device__ __forceinline__ void cv8_load(const float* W, int N, int item, int nblk, int lane, f32x4 (&v)[8]) {
    const int kb = item / nblk, nb = item - kb * nblk; const float* src = W + (size_t)(64 * kb + (lane >> 3)) * N + 32 * nb + (lane & 7) * 4;
#pragma unroll
    for (int i = 0; i < 8; ++i) v[i] = *(const f32x4*)(src + (size_t)(8 * i) * N);
}
__device__ __forceinline__ void cv8_emit(const f32x4 (&v)[8], int K, int N, unsigned char* WT, LAS float* scr, int item, int nblk, int lane) {
    const int kb = item / nblk, nb = item - kb * nblk, k0 = 64 * kb, n0 = 32 * nb;
    { LAS float* d = scr + (lane >> 3) * 33 + (lane & 7) * 4;
#pragma unroll
      for (int i = 0; i < 8; ++i) { d[(8 * i) * 33 + 0] = v[i][0]; d[(8 * i) * 33 + 1] = v[i][1]; d[(8 * i) * 33 + 2] = v[i][2]; d[(8 * i) * 33 + 3] = v[i][3]; } }
    asm volatile("s_waitcnt lgkmcnt(0)" ::: "memory");
    const int c = lane & 3;
#pragma unroll
    for (int jj = 0; jj < 2; ++jj) { const int n = (lane >> 2) + 16 * jj; const LAS float* sp = scr + (16 * c) * 33 + n;
        u32x4 o;
        o.x = pg8::pack4_fp8(32.f * sp[0 * 33], 32.f * sp[1 * 33], 32.f * sp[2 * 33], 32.f * sp[3 * 33]);     o.y = pg8::pack4_fp8(32.f * sp[4 * 33], 32.f * sp[5 * 33], 32.f * sp[6 * 33], 32.f * sp[7 * 33]);
        o.z = pg8::pack4_fp8(32.f * sp[8 * 33], 32.f * sp[9 * 33], 32.f * sp[10 * 33], 32.f * sp[11 * 33]);   o.w = pg8::pack4_fp8(32.f * sp[12 * 33], 32.f * sp[13 * 33], 32.f * sp[14 * 33], 32.f * sp[15 * 33]);
        *(u32x4*)(WT + (size_t)(n0 + n) * K + k0 + 16 * c) = o; }
    asm volatile("s_waitcnt lgkmcnt(0)" ::: "memory");
}


__device__ __forceinline__ void cvb_emit(const f32x4 (&v)[8], int K, bf16_t* WT, LAS float* scr, int item, int nblk, int lane) {
    const int kb = item / nblk, nb = item - kb * nblk, k0 = 64 * kb, n0 = 32 * nb;
    { LAS float* d = scr + (lane >> 3) * 33 + (lane & 7) * 4;
#pragma unroll
      for (int i = 0; i < 8; ++i) { d[(8 * i) * 33 + 0] = v[i][0]; d[(8 * i) * 33 + 1] = v[i][1]; d[(8 * i) * 33 + 2] = v[i][2]; d[(8 * i) * 33 + 3] = v[i][3]; } }
    asm volatile("s_waitcnt lgkmcnt(0)" ::: "memory");
    const int c = lane & 7;
#pragma unroll
    for (int j = 0; j < 4; ++j) { const int n = (lane >> 3) + 8 * j; const LAS float* s = scr + (8 * c) * 33 + n;
        u32x4 o; o.x = pk2(s[0 * 33], s[1 * 33]); o.y = pk2(s[2 * 33], s[3 * 33]); o.z = pk2(s[4 * 33], s[5 * 33]); o.w = pk2(s[6 * 33], s[7 * 33]);
        *(u32x4*)(WT + (size_t)(n0 + n) * K + k0 + 8 * c) = o; }
    asm volatile("s_waitcnt lgkmcnt(0)" ::: "memory");
}

__device__ __forceinline__ unsigned pack4_i8(float a, float b, float c, float d) {
    return ((unsigned)(int)__builtin_rintf(a) & 0xffu) | (((unsigned)(int)__builtin_rintf(b) & 0xffu) << 8) | (((unsigned)(int)__builtin_rintf(c) & 0xffu) << 16) | (((unsigned)(int)__builtin_rintf(d) & 0xffu) << 24);
}
__device__ __forceinline__ void transpose_item_i8(const float* W, int K, int N, signed char* WT, float* wsc, const float* wpm, int NC, LAS float* scr, int item, int lane) {
    const int nblk = N / 32, kb = item / nblk, nb = item % nblk, k0 = 64 * kb, n0 = 32 * nb;
#pragma unroll 8
    for (int i = 0; i < 32; ++i) { const int kk = 2 * i + (lane >> 5); scr[kk * 33 + (lane & 31)] = W[(size_t)(k0 + kk) * N + n0 + (lane & 31)]; }
    asm volatile("s_waitcnt lgkmcnt(0)" ::: "memory");
    const int c = lane & 3;
#pragma unroll
    for (int jj = 0; jj < 2; ++jj) { const int n = (lane >> 2) + 16 * jj; const LAS float* sp = scr + (16 * c) * 33 + n;
        float mx = 0.f;
#pragma unroll
        for (int q = 0; q < 16; ++q) mx = fmaxf(mx, wpm[(size_t)q * NC + n0 + n]);
        const float sv = mx * (1.0f / 127.0f); const float inv = sv > 0.f ? 1.0f / sv : 0.f;
        if (kb == 0 && c == 0) wsc[n0 + n] = sv;
        u32x4 o;
        o.x = pack4_i8(inv * sp[0 * 33], inv * sp[1 * 33], inv * sp[2 * 33], inv * sp[3 * 33]);     o.y = pack4_i8(inv * sp[4 * 33], inv * sp[5 * 33], inv * sp[6 * 33], inv * sp[7 * 33]);
        o.z = pack4_i8(inv * sp[8 * 33], inv * sp[9 * 33], inv * sp[10 * 33], inv * sp[11 * 33]);   o.w = pack4_i8(inv * sp[12 * 33], inv * sp[13 * 33], inv * sp[14 * 33], inv * sp[15 * 33]);
        *(u32x4*)(WT + (size_t)(n0 + n) * K + k0 + 16 * c) = o; }
    asm volatile("s_waitcnt lgkmcnt(0)" ::: "memory");
}
__device__ __forceinline__ void cvt_i8_seg(const float* W, signed char* WT, float* wsc, const float* wpm, int K, int N, int nmat, LAS float* scr, int gw, int ngw, int lane) {
    const int per = (K / 64) * (N / 32), total = per * nmat;
    for (int it = gw; it < total; it += ngw) { const int mi = it / per; transpose_item_i8(W + (size_t)mi * K * N, K, N, WT + (size_t)mi * K * N, wsc + (size_t)mi * N, wpm + (size_t)mi * N, N * nmat, scr, it - mi * per, lane); }
}
__device__ __forceinline__ void colscale_seg(const float* W, float* wpm, int K, int N, int nmat, int gtid, int ngt) {
    const int NC = N * nmat;
    for (int idx = gtid; idx < NC * (K / 64); idx += ngt) { const int ksp = idx / NC, cix = idx - ksp * NC, mi = cix / N, n = cix - mi * N; const float* w = W + ((size_t)mi * K + (size_t)ksp * 64) * N + n; float mx = 0.f;
        for (int k0 = 0; k0 < 64; k0 += 16) { float v[16];
#pragma unroll
            for (int u = 0; u < 16; ++u) v[u] = w[(size_t)(k0 + u) * N];
#pragma unroll
            for (int u = 0; u < 16; ++u) mx = fmaxf(mx, fabsf(v[u])); }
        wpm[idx] = mx; }
}

__device__ __forceinline__ void cvt_i8_panels(const float* W, signed char* WT, float* wsc, LAS unsigned char* lds, int bid, int G, int tid) {
    LAS float* tile = (LAS float*)lds;
    LAS float* cmx = tile + 1024 * 33;
    for (int panel = bid; panel < 256; panel += G) {
        const int mi = panel >> 7, n0 = (panel & 127) * 32, cc = tid & 31, rr = tid >> 5;
        const float* src = W + (size_t)mi * 1024 * 4096 + n0 + cc;
        for (int r0 = 0; r0 < 1024; r0 += 256) {
            float v[16];
#pragma unroll
            for (int u = 0; u < 16; ++u) v[u] = src[(size_t)(r0 + u * 16 + rr) * 4096];
#pragma unroll
            for (int u = 0; u < 16; ++u) tile[(r0 + u * 16 + rr) * 33 + cc] = v[u];
        }
        __syncthreads();
        { float mx = 0.f;
#pragma unroll 16
          for (int u = 0; u < 64; ++u) mx = fmaxf(mx, fabsf(tile[(rr * 64 + u) * 33 + cc]));
          cmx[rr * 32 + cc] = mx; }
        __syncthreads();
        if (tid < 32) { float mx = 0.f;
#pragma unroll
            for (int q = 0; q < 16; ++q) mx = fmaxf(mx, cmx[q * 32 + tid]);
            const float sv = mx * (1.0f / 127.0f); cmx[512 + tid] = sv; wsc[(size_t)mi * 4096 + n0 + tid] = sv; }
        __syncthreads();
        { const float sv = cmx[512 + cc]; const float inv = sv > 0.f ? 1.0f / sv : 0.f;
          signed char* dst = WT + ((size_t)mi * 4096 + n0 + cc) * 1024;
#pragma unroll
          for (int j = 0; j < 4; ++j) { const int ck = rr + 16 * j; const LAS float* sp = tile + (16 * ck) * 33 + cc;
              u32x4 o;
              o.x = pack4_i8(inv * sp[0 * 33], inv * sp[1 * 33], inv * sp[2 * 33], inv * sp[3 * 33]);     o.y = pack4_i8(inv * sp[4 * 33], inv * sp[5 * 33], inv * sp[6 * 33], inv * sp[7 * 33]);
              o.z = pack4_i8(inv * sp[8 * 33], inv * sp[9 * 33], inv * sp[10 * 33], inv * sp[11 * 33]);   o.w = pack4_i8(inv * sp[12 * 33], inv * sp[13 * 33], inv * sp[14 * 33], inv * sp[15 * 33]);
              *(u32x4*)(dst + 16 * ck) = o; } }
        __syncthreads();
    }
}

typedef float f32x16 __attribute__((ext_vector_type(16)));
constexpr int XB_STRIDE = 272, XB_BYTES = 256 * XB_STRIDE, HF_STRIDE = 260, HF_BYTES = 256 * HF_STRIDE;
constexpr int NCK128 = NTOK / 128;
struct LruW { const bf16_t* wt_a; const bf16_t* wt_x; };

template <int D> __device__ __forceinline__ void lru_dir(const P& p, const LruW& W, int jl, int h, int row0, LAS unsigned char* xb, LAS unsigned char* hfb, int wn, int wm, int c, int q, int lane) {
    const int j = 32 * wn + c, ch = h * 128 + j;
    const float ba = p.lru_b_a[(jl * 2 + D) * LW + ch], bx = p.lru_b_x[(jl * 2 + D) * LW + ch];
    const float k2 = p.k2tab[(jl * 2 + D) * LW + ch];
    const float nba = -1.44269504089f * ba, nbx = -1.44269504089f * bx;
    bf16x8 Ba[8], Bx[8];
    {
        const bf16_t* ga = W.wt_a + ((size_t)((jl * 2 + D) * 10 + h) * 128 + j) * 128 + 8 * q;
        const bf16_t* gx = W.wt_x + ((size_t)((jl * 2 + D) * 10 + h) * 128 + j) * 128 + 8 * q;
#pragma unroll
        for (int s = 0; s < 8; ++s) { Ba[s] = *(const bf16x8*)(ga + 16 * s); Bx[s] = *(const bf16x8*)(gx + 16 * s); }
    }
    float Hc = 0.f, Cc = 1.f;
    const bool first = (D == 0) ? (q == 0) : (q == 1);
    for (int mi = 0; mi < 4; ++mi) {
        const int m = (D == 0) ? mi : 3 - mi;
        f32x16 aa, ax;
#pragma unroll
        for (int r = 0; r < 16; ++r) { aa[r] = 0.f; ax[r] = 0.f; }
        const LAS unsigned char* arow = xb + (wm * 128 + m * 32 + (lane & 31)) * XB_STRIDE + 16 * q;
#pragma unroll
        for (int s = 0; s < 8; ++s) {
            const bf16x8 af = *(const LAS bf16x8*)(arow + 32 * s);
            aa = __builtin_amdgcn_mfma_f32_32x32x16_bf16(af, Ba[s], aa, 0, 0, 0);
            ax = __builtin_amdgcn_mfma_f32_32x32x16_bf16(af, Bx[s], ax, 0, 0, 0);
        }
        const LAS unsigned char* xcol = xb + (wm * 128 + m * 32 + 4 * q) * XB_STRIDE + j * 2;
        float hL = 0.f, cL = 1.f;
#pragma unroll
        for (int rr = 0; rr < 16; rr += 2) {
            const int rl = (D == 0) ? rr : 14 - rr;
            f32x2 xv2, za, zx;
#pragma unroll
            for (int t2 = 0; t2 < 2; ++t2) { const int r = rl + t2, i0 = (r & 3) + 8 * (r >> 2);
                xv2[t2] = __uint_as_float(((unsigned)*(const LAS unsigned short*)(xcol + i0 * XB_STRIDE)) << 16); za[t2] = aa[r]; zx[t2] = ax[r]; }
            const f32x2 nl2 = {-1.44269504089f, -1.44269504089f};
            za = __builtin_elementwise_fma(za, nl2, (f32x2){nba, nba});
            zx = __builtin_elementwise_fma(zx, nl2, (f32x2){nbx, nbx});
            f32x2 da, dx; da[0] = __builtin_amdgcn_exp2f(za[0]); da[1] = __builtin_amdgcn_exp2f(za[1]); dx[0] = __builtin_amdgcn_exp2f(zx[0]); dx[1] = __builtin_amdgcn_exp2f(zx[1]);
            da = da + 1.0f; dx = dx + 1.0f;
            f32x2 rg, ig; rg[0] = __builtin_amdgcn_rcpf(da[0]); rg[1] = __builtin_amdgcn_rcpf(da[1]); ig[0] = __builtin_amdgcn_rcpf(dx[0]); ig[1] = __builtin_amdgcn_rcpf(dx[1]);
            const f32x2 l2 = rg * k2;
            f32x2 a2; a2[0] = __builtin_amdgcn_exp2f(l2[0]); a2[1] = __builtin_amdgcn_exp2f(l2[1]);
            const f32x2 om = __builtin_elementwise_fma(-a2, a2, (f32x2){1.0f, 1.0f});
            f32x2 sq; sq[0] = __builtin_amdgcn_sqrtf(om[0]); sq[1] = __builtin_amdgcn_sqrtf(om[1]);
            const f32x2 u2 = sq * (ig * xv2);
#pragma unroll
            for (int t2 = 0; t2 < 2; ++t2) { const int q2 = (D == 0) ? t2 : 1 - t2, r = rl + q2;
                hL = a2[q2] * hL + u2[q2]; cL *= a2[q2];
                ax[r] = hL; aa[r] = cL; }
        }
        const float Ao = shx(cL, 32, lane), Ho = shx(hL, 32, lane);
        const float A_f = first ? cL : Ao, H_f = first ? hL : Ho, A_s = first ? Ao : cL, H_s = first ? Ho : hL;
        const float mid = A_f * Hc + H_f;
        const float cin = first ? Hc : mid, cpre = first ? Cc : Cc * A_f;
        Hc = A_s * mid + H_s; Cc = Cc * A_f * A_s;
        const int trow = wm * 128 + m * 32 + q * 16;
        const int odd = lane & 1;
        unsigned char* gA = ((D == 0) ? p.Af : p.Ab) + (size_t)(row0 + trow + odd) * LW + (ch - odd);
        bf16_t* gS = p.S + (size_t)(row0 + trow) * LW + ch;
        LAS unsigned char* hrow = hfb + trow * HF_STRIDE + j * 2;
        const float cpre255 = cpre * 255.0f;
#pragma unroll
        for (int r = 0; r < 16; r += 2) {
            const float cv0 = __builtin_rintf(aa[r] * cpre255), cv1 = __builtin_rintf(aa[r + 1] * cpre255);
            const float send = odd ? cv0 : cv1; const float recv = __int_as_float(__builtin_amdgcn_mov_dpp(__float_as_int(send), 0xB1, 0xF, 0xF, true));
            unsigned pk = __builtin_amdgcn_cvt_pk_u8_f32(odd ? recv : cv0, 0, 0u); pk = __builtin_amdgcn_cvt_pk_u8_f32(odd ? cv1 : recv, 1, pk);
            *(unsigned short*)(gA + (size_t)r * LW) = (unsigned short)pk;
        }
#pragma unroll
        for (int r = 0; r < 16; ++r) {
            const float hv = ax[r] + aa[r] * cin;
            if (D == 0) *(LAS unsigned short*)(hrow + r * HF_STRIDE) = f2bf(hv);
            else { const float hf = __uint_as_float(((unsigned)*(const LAS unsigned short*)(hrow + r * HF_STRIDE)) << 16); gS[(size_t)r * LW] = f2bf(hv + hf); }
        }
    }
    if (q == 0) { const int ck128 = (row0 >> 7) + wm; float* ag = p.agg + ((size_t)(ck128 * 2 + D) * 2) * LW + ch; ag[0] = Cc; ag[LW] = Hc; }
}

__device__ __forceinline__ void lru_scan_phase(const P& p, const LruW& W, int jl, LAS unsigned char* lds, int wv) {
    const Ids I = fresh_ids(wv); const int tid = I.tid, lane = I.lane, wid = I.wid, wn = wid & 3, wm = wid >> 2, c = lane & 31, q = lane >> 5;
    LAS unsigned char* xb = lds; LAS unsigned char* hfb = lds + XB_BYTES;
    for (int u = I.bid; u < NCK * 10; u += I.G) {
        const int ck = u / 10, h = u - ck * 10, row0 = ck * 256;
        int t0, T; if (ck < 32) { t0 = 0; T = 256; } else { t0 = ((ck - 32) & 15) * 256; T = 4096; }
        {
            const int chunk = tid & 15, g = tid >> 4, ch0 = h * 128 + chunk * 8;
            const float* cw = p.lru_conv_w + (size_t)jl * 4 * LW + ch0; const float* cbp = p.lru_conv_b + jl * LW + ch0;
            float w[4][8], b[8];
#pragma unroll
            for (int k = 0; k < 4; ++k) { const float4 lo = *(const float4*)(cw + k * LW), hi = *(const float4*)(cw + k * LW + 4); w[k][0] = lo.x; w[k][1] = lo.y; w[k][2] = lo.z; w[k][3] = lo.w; w[k][4] = hi.x; w[k][5] = hi.y; w[k][6] = hi.z; w[k][7] = hi.w; }
            { const float4 lo = *(const float4*)cbp, hi = *(const float4*)(cbp + 4); b[0] = lo.x; b[1] = lo.y; b[2] = lo.z; b[3] = lo.w; b[4] = hi.x; b[5] = hi.y; b[6] = hi.z; b[7] = hi.w; }
            uint4 raw[11];
#pragma unroll
            for (int k = 0; k < 11; ++k) { const int tl = g * 8 + k - 2, tt = t0 + tl; raw[k] = make_uint4(0u, 0u, 0u, 0u);
                if (tt >= 0 && tt < T) raw[k] = *(const uint4*)(p.xpre + (size_t)(row0 + tl) * LW + ch0); }
            asm volatile("" ::: "memory");
#pragma unroll
            for (int k = 0; k < 8; ++k) {
                float o[8];
#pragma unroll
                for (int e = 0; e < 8; ++e) o[e] = b[e];
#pragma unroll
                for (int tap = 0; tap < 4; ++tap) { const uint4 rw = raw[k + tap]; const unsigned ww[4] = {rw.x, rw.y, rw.z, rw.w};
#pragma unroll
                    for (int e2 = 0; e2 < 4; ++e2) { o[2 * e2] += w[tap][2 * e2] * __uint_as_float(ww[e2] << 16); o[2 * e2 + 1] += w[tap][2 * e2 + 1] * __uint_as_float(ww[e2] & 0xffff0000u); } }
                const int Tt = g * 8 + k, wmm = Tt >> 7, tl = Tt & 127, mm = tl >> 5, qq = (tl >> 4) & 1, r = tl & 15, i = (r & 3) + 8 * (r >> 2) + 4 * qq;
                u32x4 pk; pk.x = pk2(o[0], o[1]); pk.y = pk2(o[2], o[3]); pk.z = pk2(o[4], o[5]); pk.w = pk2(o[6], o[7]);
                *(LAS u32x4*)(xb + (wmm * 128 + mm * 32 + i) * XB_STRIDE + chunk * 16) = pk;
            }
        }
        __syncthreads();
        lru_dir<0>(p, W, jl, h, row0, xb, hfb, wn, wm, c, q, lane);
        lru_dir<1>(p, W, jl, h, row0, xb, hfb, wn, wm, c, q, lane);
        __syncthreads();
    }
}
__device__ __forceinline__ void lru_fix_phase(const P& p, int jl, int wv) {
    const Ids I = fresh_ids(wv);
    for (int it = I.bid * 512 + I.tid; it < NCK128 * 4 * 160; it += I.G * 512) {
        const int cg = it % 160, rq = (it / 160) & 3, ck = it / 640, ch0 = cg * 8;
        int seq, pos, nch, base; bool smp = ck >= 64;
        if (!smp) { seq = ck >> 1; pos = ck & 1; nch = 2; base = seq * 2; } else { const int c2 = ck - 64; seq = c2 >> 5; pos = c2 & 31; nch = 32; base = 64 + seq * 32; }
        float cf[8], cb[8];
#pragma unroll
        for (int e = 0; e < 8; ++e) { cf[e] = 0.f; cb[e] = 0.f; }
        if (smp) { const float* s0 = p.state_lru + ((size_t)(seq * 2 + jl) * 2) * LW + ch0;
#pragma unroll
            for (int e = 0; e < 8; ++e) { cf[e] = s0[e]; cb[e] = s0[LW + e]; } }
        for (int k = 0; k < pos; ++k) { const float* a = p.agg + ((size_t)((base + k) * 2 + 0) * 2) * LW + ch0;
#pragma unroll
            for (int e = 0; e < 8; ++e) cf[e] = a[e] * cf[e] + a[LW + e]; }
        for (int k = nch - 1; k > pos; --k) { const float* a = p.agg + ((size_t)((base + k) * 2 + 1) * 2) * LW + ch0;
#pragma unroll
            for (int e = 0; e < 8; ++e) cb[e] = a[e] * cb[e] + a[LW + e]; }
        if (!smp && rq == 0) {
            const float* a = p.agg + ((size_t)(ck * 2 + (pos ? 0 : 1)) * 2) * LW + ch0;
            float* ns = p.new_state + ((size_t)(seq * 2 + jl) * 2 + (pos ? 0 : 1)) * LW + ch0;
#pragma unroll
            for (int e = 0; e < 8; ++e) ns[e] = a[e] * (pos ? cf[e] : cb[e]) + a[LW + e];
        }
        const size_t o0 = (size_t)(ck * 128 + rq * 32) * LW + ch0;
#pragma unroll
        for (int e = 0; e < 8; ++e) { cf[e] *= (1.0f / 255.0f); cb[e] *= (1.0f / 255.0f); }
        for (int t = 0; t < 32; ++t) { const size_t o = o0 + (size_t)t * LW;
            const uint4 s = *(const uint4*)(p.S + o), gt = *(const uint4*)(p.gate + o); const u32x2 af = *(const u32x2*)(p.Af + o), ab = *(const u32x2*)(p.Ab + o);
            const unsigned sw[4] = {s.x, s.y, s.z, s.w}, gw[4] = {gt.x, gt.y, gt.z, gt.w};
            unsigned ow[4];
#pragma unroll
            for (int e2 = 0; e2 < 4; ++e2) {
                const unsigned fq = af[e2 >> 1] >> (16 * (e2 & 1)), bq = ab[e2 >> 1] >> (16 * (e2 & 1));
                const float lo = (__uint_as_float(sw[e2] << 16) + (float)(fq & 0xffu) * cf[2 * e2] + (float)(bq & 0xffu) * cb[2 * e2]) * __uint_as_float(gw[e2] << 16);
                const float hi = (__uint_as_float(sw[e2] & 0xffff0000u) + (float)((fq >> 8) & 0xffu) * cf[2 * e2 + 1] + (float)((bq >> 8) & 0xffu) * cb[2 * e2 + 1]) * __uint_as_float(gw[e2] & 0xffff0000u);
                ow[e2] = pk2(lo, hi); }
            *(uint4*)(p.zl + o) = make_uint4(ow[0], ow[1], ow[2], ow[3]); }
    }
}
typedef short s16x4 __attribute__((ext_vector_type(4)));
__device__ __forceinline__ unsigned off_b(unsigned row, unsigned ch) { return 256u * row + 16u * (ch ^ (((row & 3) << 2) | ((row >> 2) & 3))); }
__device__ __forceinline__ unsigned tr_read_addr(unsigned lane, unsigned c, unsigned ks, unsigned t) {
    const unsigned h = lane >> 5, blk = (lane >> 4) & 1, q = (lane & 15) >> 2, pp = lane & 3;
    return off_b(16 * ks + 8 * h + 4 * t + q, 4 * c + 2 * blk + (pp >> 1)) + 8 * (pp & 1);
}
__device__ __forceinline__ void sgu_phase(const P& p, int jl, LAS unsigned char* lds, int wv) {
    const Ids I = fresh_ids(wv); const int tid = I.tid, lane = I.lane, wid = I.wid;
    LAS unsigned char* Aimg = lds; LAS unsigned char* Vimg = lds + 32768; LAS unsigned char* stage = lds;
    LAS float* rsb = (LAS float*)(lds + 98304); LAS float* bsl = rsb + 256;
    constexpr int NU = (NTOK / 128) * 8, SST = 528;
    u32x4 vreg[8], ureg[8]; float4 wlo[4], whi[4];
    int u = I.bid;
    if (u >= NU) return;
    const unsigned vo_v = (unsigned)((tid >> 5) * 8192 + (tid & 31) * 16), vo_z = (unsigned)((tid >> 5) * 4096 + (tid & 31) * 16), vo_w = (unsigned)(((tid >> 4) * 128 + (tid & 15) * 8) * 4);
#define SG_ISSUE(uu) do { const int n_ = (uu) >> 3, g_ = (uu) & 7; const char* vb_ = (const char*)(p.proj + (size_t)n_ * 128 * 4096 + 2048 + g_ * 256); const char* wb_ = (const char*)(p.sg_w_s + (size_t)(jl * 8 + g_) * 128 * 128); \
        _Pragma("unroll") for (int k = 0; k < 8; ++k) vreg[k] = *(const u32x4*)(vb_ + (size_t)k * 16 * 8192 + vo_v); \
        _Pragma("unroll") for (int k = 0; k < 4; ++k) { const char* wk_ = wb_ + (size_t)k * 32 * 512 + vo_w; wlo[k] = *(const float4*)wk_; whi[k] = *(const float4*)(wk_ + 16); } } while (0)
#define SG_RS(uu, bf) do { if (tid < 128) { const int n_ = (uu) >> 3, g_ = (uu) & 7; const float4* vp = (const float4*)(p.vss + (size_t)(n_ * 128 + tid) * 32); float sacc = 0.f; \
        _Pragma("unroll") for (int k = 0; k < 8; ++k) { const float4 v = vp[k]; sacc += (v.x + v.y) + (v.z + v.w); } \
        rsb[(bf) * 128 + tid] = rsqrtf(sacc * (1.0f / 2048.0f) + RMS_EPS); bsl[(bf) * 128 + tid] = p.sg_b_s[(jl * 8 + g_) * 128 + tid]; } } while (0)
    SG_ISSUE(u); SG_RS(u, 0);
    int buf = 0;
    for (; u < NU; u += I.G) {
        const int n = u >> 3, g = u & 7, row0 = n * 128;
        __syncthreads();
#pragma unroll
        for (int k = 0; k < 8; ++k) { const int it = tid + 512 * k, qq = it >> 5, cch = it & 31; *(LAS u32x4*)(Vimg + (cch >> 4) * 32768 + off_b(qq, cch & 15)) = vreg[k]; }
#pragma unroll
        for (int k = 0; k < 4; ++k) { const int it = tid + 512 * k, pp = it >> 4, chq = it & 15; const LAS float* r8 = rsb + buf * 128 + chq * 8;
            u32x4 pk; pk.x = pk2(wlo[k].x * r8[0], wlo[k].y * r8[1]); pk.y = pk2(wlo[k].z * r8[2], wlo[k].w * r8[3]); pk.z = pk2(whi[k].x * r8[4], whi[k].y * r8[5]); pk.w = pk2(whi[k].z * r8[6], whi[k].w * r8[7]);
            *(LAS u32x4*)(Aimg + off_b(pp, chq)) = pk; }
#pragma unroll
        for (int k = 0; k < 8; ++k) ureg[k] = *(const u32x4*)((const char*)(p.proj + (size_t)row0 * 4096 + g * 256) + (size_t)k * 16 * 8192 + vo_v);
        const int gcol = g * 256 + 32 * wid + (lane & 31); const float ng = p.sg_norm_g[jl * SGW + gcol];
        __syncthreads();
        f32x16 acc[4];
#pragma unroll
        for (int m = 0; m < 4; ++m)
#pragma unroll
            for (int r = 0; r < 16; ++r) acc[m][r] = 0.f;
        const LAS unsigned char* vb = Vimg + (wid >> 2) * 32768; const unsigned cblk = wid & 3;
#pragma unroll
        for (int s2 = 0; s2 < 8; ++s2) {
            const s16x4 b0 = __builtin_amdgcn_ds_read_tr16_b64_v4i16((LAS s16x4*)(vb + tr_read_addr(lane, cblk, s2, 0)));
            const s16x4 b1 = __builtin_amdgcn_ds_read_tr16_b64_v4i16((LAS s16x4*)(vb + tr_read_addr(lane, cblk, s2, 1)));
            bf16x8 B; B[0] = b0[0]; B[1] = b0[1]; B[2] = b0[2]; B[3] = b0[3]; B[4] = b1[0]; B[5] = b1[1]; B[6] = b1[2]; B[7] = b1[3];
#pragma unroll
            for (int m = 0; m < 4; ++m) { const bf16x8 A = *(const LAS bf16x8*)(Aimg + off_b(32 * m + (lane & 31), 2 * s2 + (lane >> 5))); acc[m] = __builtin_amdgcn_mfma_f32_32x32x16_bf16(A, B, acc[m], 0, 0, 0); }
        }
        __syncthreads();
        { LAS unsigned char* scol = stage + (32 * wid + (lane & 31)) * 2; const LAS float* bb = bsl + buf * 128;
#pragma unroll
          for (int m = 0; m < 4; ++m)
#pragma unroll
            for (int r = 0; r < 16; ++r) { const int pp = 32 * m + (r & 3) + 8 * (r >> 2) + 4 * (lane >> 5);
                *(LAS unsigned short*)(scol + pp * SST) = f2bf(acc[m][r] * ng + bb[pp]); } }
        const int un = u + I.G;
        if (un < NU) { SG_ISSUE(un); SG_RS(un, buf ^ 1); }
        __syncthreads();
#pragma unroll
        for (int k = 0; k < 8; ++k) { const int it = tid + 512 * k, pp = it >> 5, cch = it & 31;
            const u32x4 sv = *(const LAS u32x4*)(stage + pp * SST + cch * 16); const u32x4 uu = ureg[k]; u32x4 o;
            o.x = pk2(__uint_as_float(sv.x << 16) * __uint_as_float(uu.x << 16), __uint_as_float(sv.x & 0xffff0000u) * __uint_as_float(uu.x & 0xffff0000u));
            o.y = pk2(__uint_as_float(sv.y << 16) * __uint_as_float(uu.y << 16), __uint_as_float(sv.y & 0xffff0000u) * __uint_as_float(uu.y & 0xffff0000u));
            o.z = pk2(__uint_as_float(sv.z << 16) * __uint_as_float(uu.z << 16), __uint_as_float(sv.z & 0xffff0000u) * __uint_as_float(uu.z & 0xffff0000u));
            o.w = pk2(__uint_as_float(sv.w << 16) * __uint_as_float(uu.w << 16), __uint_as_float(sv.w & 0xffff0000u) * __uint_as_float(uu.w & 0xffff0000u));
            *(u32x4*)((char*)(p.zsg + (size_t)row0 * SGW + g * 256) + (size_t)k * 16 * 4096 + vo_z) = o; }
        buf ^= 1;
    }
#undef SG_ISSUE
#undef SG_RS
}


#define PIN8(a, b, c, d, e, f, g, h) asm volatile("" : "+v"(a), "+v"(b), "+v"(c), "+v"(d), "+v"(e), "+v"(f), "+v"(g), "+v"(h) :: "memory")
#define PIN4(a, b, c, d) asm volatile("" : "+v"(a), "+v"(b), "+v"(c), "+v"(d) :: "memory")

__device__ __forceinline__ void rowA_phase(const P& p, int l, int wv, bool dry = false) {
    const Ids I = fresh_ids(wv); const int lane = I.lane;
    constexpr int NPAIR = NTOK / 2;
    int pr = I.gw, s_cur = -1;
    float pfreq[4];
#pragma unroll
    for (int q = 0; q < 4; ++q) pfreq[q] = (l == 0) ? expf(-9.210340371976184f * (float)(4 * lane + q) / 256.0f) : 0.f;
    if (l > 0 && pr < NPAIR && lane < 32) s_cur = p.inv[(size_t)(lane & 15) * NTOK + 2 * pr + (lane >> 4)];
    for (; pr < NPAIR; pr += I.ngw) {
        const int r0 = 2 * pr, ci = tok_cond(r0), prn = pr + I.ngw;
        int s_nxt = -1;
        if (l > 0 && prn < NPAIR && lane < 32) s_nxt = p.inv[(size_t)(lane & 15) * NTOK + 2 * prn + (lane >> 4)];
        float4 xv[2][4];
        if (l == 0) {
#pragma unroll
            for (int rr = 0; rr < 2; ++rr) { const int r = r0 + rr;
                if (r < NCTX) {
#pragma unroll
                    for (int j = 0; j < 4; ++j) xv[rr][j] = *(const float4*)(p.x_prompt + (size_t)r * DM + 4 * lane + 256 * j);
                } else {
                    const int rs = r - NCTX, t = rs & 4095; const float frow = (float)(t >> 6), fcol = (float)(t & 63);
#pragma unroll
                    for (int j = 0; j < 4; ++j) {
                        float4 v = *(const float4*)(p.x_sample + (size_t)rs * DM + 4 * lane + 256 * j);
                        float e[4];
#pragma unroll
                        for (int q = 0; q < 4; ++q) { const float ang = (j < 2 ? frow : fcol) * pfreq[q]; e[q] = (j & 1) ? __cosf(ang) : __sinf(ang); }
                        v.x += e[0]; v.y += e[1]; v.z += e[2]; v.w += e[3]; xv[rr][j] = v;
                    }
                }
            }
        } else {
            u32x2 xr4[2][4];
#pragma unroll
            for (int rr = 0; rr < 2; ++rr)
#pragma unroll
                for (int j = 0; j < 4; ++j) xr4[rr][j] = *(const u32x2*)(p.x + (size_t)(r0 + rr) * DM + 4 * lane + 256 * j);
            const unsigned long long bal = __ballot(s_cur >= 0);
            unsigned buf[2][4][4]; unsigned nsel[2], rem[2];
#pragma unroll
            for (int rr = 0; rr < 2; ++rr) {
                unsigned m = (unsigned)__builtin_amdgcn_readfirstlane((int)((bal >> (16 * rr)) & 0xffffull)); nsel[rr] = (unsigned)__builtin_popcount(m);
#pragma unroll
                for (int k = 0; k < 4; ++k) if (m) { const int e = __builtin_ctz(m); m &= m - 1u; const int slot = __builtin_amdgcn_readlane(s_cur, 16 * rr + e);
                    const unsigned char* orow = p.outm + (size_t)slot * DM + 4 * lane;
#pragma unroll
                    for (int j = 0; j < 4; ++j) buf[rr][k][j] = *(const unsigned*)(orow + 256 * j); }
                rem[rr] = m;
            }
            PIN8(xr4[0][0], xr4[0][1], xr4[0][2], xr4[0][3], xr4[1][0], xr4[1][1], xr4[1][2], xr4[1][3]);
#pragma unroll
            for (int rr = 0; rr < 2; ++rr)
#pragma unroll
                for (int k = 0; k < 4; k += 2) PIN8(buf[rr][k][0], buf[rr][k][1], buf[rr][k][2], buf[rr][k][3], buf[rr][k + 1][0], buf[rr][k + 1][1], buf[rr][k + 1][2], buf[rr][k + 1][3]);
#pragma unroll
            for (int rr = 0; rr < 2; ++rr)
#pragma unroll
                for (int j = 0; j < 4; ++j) xv[rr][j] = xs_unpack(xr4[rr][j]);
            const float* g2 = p.mod + (size_t)((l - 1) * 9 + ci) * 6144 + 5 * 1024;
#pragma unroll
            for (int rr = 0; rr < 2; ++rr) {
                float4 acc[4];
#pragma unroll
                for (int j = 0; j < 4; ++j) acc[j] = make_float4(0.f, 0.f, 0.f, 0.f);
#pragma unroll
                for (int k = 0; k < 4; ++k) if (nsel[rr] > (unsigned)k) {
#pragma unroll
                    for (int j = 0; j < 4; ++j) { const f32x2 lo = __builtin_amdgcn_cvt_pk_f32_fp8((int)buf[rr][k][j], false), hi = __builtin_amdgcn_cvt_pk_f32_fp8((int)buf[rr][k][j], true); acc[j].x += lo[0]; acc[j].y += lo[1]; acc[j].z += hi[0]; acc[j].w += hi[1]; } }
                unsigned m = rem[rr];
                while (m) { const int e = __builtin_ctz(m); m &= m - 1u; const int slot = __builtin_amdgcn_readlane(s_cur, 16 * rr + e); const unsigned char* orow = p.outm + (size_t)slot * DM + 4 * lane;
#pragma unroll
                    for (int j = 0; j < 4; ++j) { const unsigned w = *(const unsigned*)(orow + 256 * j); const f32x2 lo = __builtin_amdgcn_cvt_pk_f32_fp8((int)w, false), hi = __builtin_amdgcn_cvt_pk_f32_fp8((int)w, true); acc[j].x += lo[0]; acc[j].y += lo[1]; acc[j].z += hi[0]; acc[j].w += hi[1]; } }
#pragma unroll
                for (int j = 0; j < 4; ++j) { const float4 g = *(const float4*)(g2 + 4 * lane + 256 * j);
                    xv[rr][j].x += 0.0625f * g.x * acc[j].x; xv[rr][j].y += 0.0625f * g.y * acc[j].y; xv[rr][j].z += 0.0625f * g.z * acc[j].z; xv[rr][j].w += 0.0625f * g.w * acc[j].w; }
            }
        }
        const float* md = p.mod + (size_t)((l < 4 ? l : 0) * 9 + ci) * 6144;
        float4 gsv[4], shv[4];
        { f32x4 pg[4], psc[4], psh[4];
#pragma unroll
          for (int j = 0; j < 4; ++j) { const int c0 = 4 * lane + 256 * j;
            if (l < 4) { pg[j] = *(const f32x4*)(p.norm1_g + l * 1024 + c0); psc[j] = *(const f32x4*)(md + 1024 + c0); psh[j] = *(const f32x4*)(md + c0); }
            else { pg[j] = *(const f32x4*)(p.final_norm_g + c0); psc[j] = (f32x4){0.f, 0.f, 0.f, 0.f}; psh[j] = (f32x4){0.f, 0.f, 0.f, 0.f}; } }
          PIN8(pg[0], pg[1], pg[2], pg[3], psc[0], psc[1], psc[2], psc[3]); PIN4(psh[0], psh[1], psh[2], psh[3]);
#pragma unroll
          for (int j = 0; j < 4; ++j) { shv[j] = make_float4(psh[j][0], psh[j][1], psh[j][2], psh[j][3]);
            gsv[j] = make_float4(pg[j][0] * (1.f + psc[j][0]), pg[j][1] * (1.f + psc[j][1]), pg[j][2] * (1.f + psc[j][2]), pg[j][3] * (1.f + psc[j][3])); } }
#pragma unroll
        for (int rr = 0; rr < 2; ++rr) {
            const int r = r0 + rr; bf16_t* xw = (dry ? p.gate : p.x) + (size_t)r * DM;
            float ss = 0.f;
#pragma unroll
            for (int j = 0; j < 4; ++j) { if (l < 4) { const u32x2 o = xs_pack(xv[rr][j]); *(u32x2*)(xw + 4 * lane + 256 * j) = o; xv[rr][j] = xs_unpack(o); }
                ss += xv[rr][j].x * xv[rr][j].x + xv[rr][j].y * xv[rr][j].y + xv[rr][j].z * xv[rr][j].z + xv[rr][j].w * xv[rr][j].w; }
            ss = wave_sum(ss, lane);
            const float rstd = rsqrtf(ss * (1.0f / 1024.0f) + RMS_EPS);
            if (l < 4) {
                if (l & 1) {
                float4 hv[4]; float amax = 0.f;
#pragma unroll
                for (int j = 0; j < 4; ++j) { const float4 gs = gsv[j], sh = shv[j];
                    hv[j] = make_float4(xv[rr][j].x * rstd * gs.x + sh.x, xv[rr][j].y * rstd * gs.y + sh.y, xv[rr][j].z * rstd * gs.z + sh.z, xv[rr][j].w * rstd * gs.w + sh.w);
                    amax = fmaxf(fmaxf(amax, fmaxf(fabsf(hv[j].x), fabsf(hv[j].y))), fmaxf(fabsf(hv[j].z), fabsf(hv[j].w))); }
#pragma unroll
                for (int o = 32; o >= 1; o >>= 1) amax = fmaxf(amax, shx(amax, o, lane));
                const float inv = amax > 0.f ? 127.0f / amax : 0.f;
                if (lane == 0) p.hsc[r] = amax * (1.0f / 127.0f);
                signed char* hr = p.hn8i + (size_t)r * DM;
#pragma unroll
                for (int j = 0; j < 4; ++j) *(unsigned*)(hr + 4 * lane + 256 * j) = pack4_i8(inv * hv[j].x, inv * hv[j].y, inv * hv[j].z, inv * hv[j].w);
                } else {
                bf16_t* hr = p.hn + (size_t)r * DM;
#pragma unroll
                for (int j = 0; j < 4; ++j) { const int c0 = 4 * lane + 256 * j; const float4 gs = gsv[j], sh = shv[j];
                    const float a = xv[rr][j].x * rstd * gs.x + sh.x, b = xv[rr][j].y * rstd * gs.y + sh.y, c = xv[rr][j].z * rstd * gs.z + sh.z, d = xv[rr][j].w * rstd * gs.w + sh.w;
                    uint2 w; w.x = (unsigned)f2bf(a) | ((unsigned)f2bf(b) << 16); w.y = (unsigned)f2bf(c) | ((unsigned)f2bf(d) << 16);
                    *(uint2*)(hr + c0) = w; }
                }
            } else {
#pragma unroll
                for (int j = 0; j < 4; ++j) { const int c0 = 4 * lane + 256 * j; const float4 g = gsv[j];
                    float4 o; o.x = xv[rr][j].x * rstd * g.x; o.y = xv[rr][j].y * rstd * g.y; o.z = xv[rr][j].z * rstd * g.z; o.w = xv[rr][j].w * rstd * g.w;
                    *(float4*)((dry ? (float*)p.gate : p.xout) + (size_t)r * DM + c0) = o; }
            }
        }
        s_cur = s_nxt;
    }
}

__device__ __forceinline__ void rowB_phase(const P& p, int l, LAS unsigned char* lds, int wv, bool dry = false) {
    const Ids I = fresh_ids(wv); const int tid = I.tid, lane = I.lane, gw = I.gw, ngw = I.ngw;
    LAS float* rT = (LAS float*)lds;
    { const float* rt = p.moe_router + (size_t)l * 1024 * 16;
      f32x4 rv[8];
#pragma unroll
      for (int q = 0; q < 8; ++q) rv[q] = *(const f32x4*)(rt + 4 * (tid + 512 * q));
#pragma unroll
      for (int q = 0; q < 8; ++q) { const int i = 4 * (tid + 512 * q), k = i >> 4, e = i & 15;
          f32x2 lo2; lo2[0] = rv[q][0]; lo2[1] = rv[q][1]; f32x2 hi2; hi2[0] = rv[q][2]; hi2[1] = rv[q][3];
          const int sl = (k & 1) * 2, pl0 = (((e >> 1) * 2 + ((k >> 1) & 1)) * 256 + (k >> 2)) * 4 + sl, pl1 = ((((e >> 1) + 1) * 2 + ((k >> 1) & 1)) * 256 + (k >> 2)) * 4 + sl;
          *(LAS f32x2*)(rT + pl0) = lo2; *(LAS f32x2*)(rT + pl1) = hi2; } }
    __syncthreads();
    for (int grp = gw; grp < NTOK / 4; grp += ngw) {
        const int r0 = grp * 4, ci = tok_cond(r0);
        const float* md = p.mod + (size_t)(l * 9 + ci) * 6144;
        float4 xv[4][4]; float rstd[4];
        f32x4 pg[4], psc[4], psh[4];
        {
            u32x2 xr4[4][4];
#pragma unroll
            for (int rr = 0; rr < 4; ++rr)
#pragma unroll
                for (int j = 0; j < 4; ++j) xr4[rr][j] = *(const u32x2*)(p.x + (size_t)(r0 + rr) * DM + 4 * lane + 256 * j);
#pragma unroll
            for (int j = 0; j < 4; ++j) { const int c0 = 4 * lane + 256 * j; pg[j] = *(const f32x4*)(p.norm2_g + l * 1024 + c0); psc[j] = *(const f32x4*)(md + 4096 + c0); psh[j] = *(const f32x4*)(md + 3072 + c0); }
#pragma unroll
            for (int rr = 0; rr < 4; rr += 2) { PIN8(xr4[rr][0], xr4[rr][1], xr4[rr][2], xr4[rr][3], xr4[rr + 1][0], xr4[rr + 1][1], xr4[rr + 1][2], xr4[rr + 1][3]); }
#pragma unroll
            for (int rr = 0; rr < 4; ++rr)
#pragma unroll
                for (int j = 0; j < 4; ++j) xv[rr][j] = xs_unpack(xr4[rr][j]);
        }
        float4 gsv[4], shv[4];
        {
          PIN8(pg[0], pg[1], pg[2], pg[3], psc[0], psc[1], psc[2], psc[3]); PIN4(psh[0], psh[1], psh[2], psh[3]);
#pragma unroll
          for (int j = 0; j < 4; ++j) { shv[j] = make_float4(psh[j][0], psh[j][1], psh[j][2], psh[j][3]);
            gsv[j] = make_float4(pg[j][0] * (1.f + psc[j][0]), pg[j][1] * (1.f + psc[j][1]), pg[j][2] * (1.f + psc[j][2]), pg[j][3] * (1.f + psc[j][3])); } }
#pragma unroll
        for (int rr = 0; rr < 4; ++rr) { float ss = 0.f;
#pragma unroll
            for (int j = 0; j < 4; ++j) { const float4 v = xv[rr][j]; ss += v.x * v.x + v.y * v.y + v.z * v.z + v.w * v.w; }
            rstd[rr] = rsqrtf(wave_sum(ss, lane) * (1.0f / 1024.0f) + RMS_EPS);
        }
        float lg[64];
#pragma unroll
        for (int i = 0; i < 64; ++i) lg[i] = 0.f;
#pragma unroll
        for (int j = 0; j < 4; ++j) { const int c0 = 4 * lane + 256 * j;
            const float4 gs = gsv[j], sh = shv[j];
            float4 h[4];
#pragma unroll
            for (int rr = 0; rr < 4; ++rr) { const float4 v = xv[rr][j]; const float rs = rstd[rr];
                h[rr] = make_float4(v.x * rs * gs.x + sh.x, v.y * rs * gs.y + sh.y, v.z * rs * gs.z + sh.z, v.w * rs * gs.w + sh.w);
                *(unsigned*)(p.hn8 + (size_t)(r0 + rr) * DM + c0) = pg8::pack4_fp8(h[rr].x, h[rr].y, h[rr].z, h[rr].w); }
            if (!(dry && PROBE_KIND == 12))
#pragma unroll
            for (int eg = 0; eg < 4; ++eg) {
                f32x4 wa[2], wb[2];
#pragma unroll
                for (int q = 0; q < 2; ++q) { const int ep = eg * 2 + q, kg = c0 >> 2; wa[q] = *(const LAS f32x4*)(rT + ((ep * 2 + 0) * 256 + kg) * 4); wb[q] = *(const LAS f32x4*)(rT + ((ep * 2 + 1) * 256 + kg) * 4); }
#pragma unroll
                for (int q = 0; q < 2; ++q)
#pragma unroll
                    for (int rr = 0; rr < 4; ++rr) { const int li = rr * 16 + (eg * 2 + q) * 2;
                        f32x2 acc; acc[0] = lg[li]; acc[1] = lg[li + 1];
                        f32x2 w0; w0[0] = wa[q][0]; w0[1] = wa[q][1]; f32x2 w1; w1[0] = wa[q][2]; w1[1] = wa[q][3]; f32x2 w2; w2[0] = wb[q][0]; w2[1] = wb[q][1]; f32x2 w3; w3[0] = wb[q][2]; w3[1] = wb[q][3];
                        f32x2 hx; hx[0] = h[rr].x; hx[1] = h[rr].x; f32x2 hy; hy[0] = h[rr].y; hy[1] = h[rr].y; f32x2 hz; hz[0] = h[rr].z; hz[1] = h[rr].z; f32x2 hw; hw[0] = h[rr].w; hw[1] = h[rr].w;
                        acc = __builtin_elementwise_fma(hx, w0, acc); acc = __builtin_elementwise_fma(hy, w1, acc); acc = __builtin_elementwise_fma(hz, w2, acc); acc = __builtin_elementwise_fma(hw, w3, acc);
                        lg[li] = acc[0]; lg[li + 1] = acc[1]; }
                __builtin_amdgcn_sched_barrier(0);
            }
        }
#pragma unroll
        for (int n = 32; n >= 1; n >>= 1) { const bool hi = (lane & n) != 0;
#pragma unroll
            for (int i = 0; i < n; ++i) { const float send = hi ? lg[i] : lg[i + n]; const float recv = shx(send, n, lane); lg[i] = (hi ? lg[i + n] : lg[i]) + recv; } }
        const float v = lg[0];
        float mx = v;
#pragma unroll
        for (int o = 8; o >= 1; o >>= 1) mx = fmaxf(mx, shx(mx, o, lane));
        const float ex = __expf(v - mx); float sm = ex;
#pragma unroll
        for (int o = 8; o >= 1; o >>= 1) sm += shx(sm, o, lane);
        p.affT[(size_t)(lane & 15) * NTOK + r0 + (lane >> 4)] = ex / sm;
        if (PROBE_KIND >= 16 && PROBE_KIND <= 17) p.affT2[(size_t)(lane & 15) * NTOK + r0 + (lane >> 4)] = ex / sm;
    }
}

__device__ __forceinline__ void mod_phase(const P& p, LAS unsigned char* lds, int wv) {
    const Ids I = fresh_ids(wv); const int bid = I.bid, tid = I.tid;
    { const int i = bid * 512 + tid; if (i < 4 * LW) { const float lam = p.lru_lam[i]; const float sp = (-lam > 20.f) ? -lam : log1pf(expf(-lam)); p.k2tab[i] = -8.0f * sp * 1.44269504089f; } }
    LAS float* sc = (LAS float*)lds; LAS float* red = sc + 1024 * 12;
    for (int i = tid; i < 9 * 1024; i += 512) { const int ci = i >> 10, k = i & 1023; const float v = ci == 0 ? p.c_ctx[k] : p.c[(ci - 1) * 1024 + k]; sc[k * 12 + ci] = v / (1.0f + __expf(-v)); }
    __syncthreads();
    for (int unit = bid; unit < 256; unit += I.G) {
        const int l = unit >> 6, n0 = (unit & 63) * 96, col = tid % 96, ks = tid / 96;
        if (ks < 5) {
            float acc[9];
#pragma unroll
            for (int ci = 0; ci < 9; ++ci) acc[ci] = 0.f;
            const int kb = ks * 208, nk = ks == 4 ? 192 : 208;
            const float* w = p.w_mod + ((size_t)l * 1024 + kb) * 6144 + n0 + col;
            const LAS float* scp = sc + kb * 12;
            for (int k0 = 0; k0 < nk; k0 += 16) {
                float wq[16];
#pragma unroll
                for (int u = 0; u < 16; ++u) wq[u] = w[(size_t)(k0 + u) * 6144];
#pragma unroll
                for (int u = 0; u < 16; ++u) { const LAS float* q = scp + (k0 + u) * 12; const f32x4 a = *(const LAS f32x4*)q, b = *(const LAS f32x4*)(q + 4); const float c8 = q[8];
                    acc[0] += a[0] * wq[u]; acc[1] += a[1] * wq[u]; acc[2] += a[2] * wq[u]; acc[3] += a[3] * wq[u];
                    acc[4] += b[0] * wq[u]; acc[5] += b[1] * wq[u]; acc[6] += b[2] * wq[u]; acc[7] += b[3] * wq[u]; acc[8] += c8 * wq[u]; }
            }
#pragma unroll
            for (int ci = 0; ci < 9; ++ci) red[(ks * 9 + ci) * 96 + col] = acc[ci];
        }
        __syncthreads();
        for (int o = tid; o < 9 * 96; o += 512) { const int ci = o / 96, cc = o - ci * 96;
            float sacc = 0.f;
#pragma unroll
            for (int q = 0; q < 5; ++q) sacc += red[(q * 9 + ci) * 96 + cc];
            p.mod[(size_t)(l * 9 + ci) * 6144 + n0 + cc] = sacc + p.b_mod[l * 6144 + n0 + cc]; }
        __syncthreads();
    }
}
__device__ __forceinline__ void cvt_seg(const float* W, bf16_t* WT, int K, int N, int nmat, LAS float* scr, int gw, int ngw, int lane) {
    const int nblk = N / 32, per = (K / 64) * nblk, total = per * nmat;
    int it = gw; if (it >= total) return;
    f32x4 cur[8], nxt[8];
    { const int mi = it / per; cv8_load(W + (size_t)mi * K * N, N, it - mi * per, nblk, lane, cur); }
    for (; it < total; it += ngw) {
        const int itn = (it + ngw < total) ? it + ngw : it;
        { const int mn = itn / per; cv8_load(W + (size_t)mn * K * N, N, itn - mn * per, nblk, lane, nxt); }
        asm volatile("" ::: "memory");
        const int mi = it / per;
        cvb_emit(cur, K, WT + (size_t)mi * K * N, scr, it - mi * per, nblk, lane);
#pragma unroll
        for (int i = 0; i < 8; ++i) cur[i] = nxt[i];
    }
}
__device__ __forceinline__ void cvt8_seg(const float* W, unsigned char* WT, int K, int N, LAS float* scr, int gw, int ngw, int lane, int lo, int total) {
    const int nblk = N / 32, per = (K / 64) * nblk;
    int it = lo + gw; if (it >= total) return;
    f32x4 cur[8], nxt[8];
    { const int mi = it / per; cv8_load(W + (size_t)mi * K * N, N, it - mi * per, nblk, lane, cur); }
    for (; it < total; it += ngw) {
        const int itn = (it + ngw < total) ? it + ngw : it;
        { const int mn = itn / per; cv8_load(W + (size_t)mn * K * N, N, itn - mn * per, nblk, lane, nxt); }
        asm volatile("" ::: "memory");
        const int mi = it / per;
        cv8_emit(cur, K, N, WT + (size_t)mi * K * N, scr, it - mi * per, nblk, lane);
#pragma unroll
        for (int i = 0; i < 8; ++i) cur[i] = nxt[i];
    }
}
__device__ __forceinline__ void cvt_moe_layer(const P& p, int l, LAS float* scr, int gw, int ngw, int lane, int ilo, int ihi) {
    unsigned char* dst = p.wt8 + (size_t)l * 3 * 16 * 1024 * 1024; const size_t lo = (size_t)l * 16 * 1024 * 1024;
    cvt8_seg(p.moe_w_gate + lo, dst, 1024, 1024, scr, gw, ngw, lane, ilo, ihi);
    cvt8_seg(p.moe_w_up + lo, dst + (size_t)16 * 1024 * 1024, 1024, 1024, scr, gw, ngw, lane, ilo, ihi);
    cvt8_seg(p.moe_w_down + lo, dst + (size_t)32 * 1024 * 1024, 1024, 1024, scr, gw, ngw, lane, ilo, ihi);
}
#define IDLE_CVT(nunits, ilo, ihi) do { const Ids Ic = fresh_ids(wv); const int rem_ = (nunits) % Ic.G; if (Ic.bid >= rem_) \
        cvt_moe_layer(p, l, (LAS float*)(lds + Ic.wid * 8704), (Ic.bid - rem_) * 8 + Ic.wid, (Ic.G - rem_) * 8, Ic.lane, (ilo), (ihi)); } while (0)

constexpr int LDS_TAB_OFF = 131072, LDS_MISC_OFF = 147456, LDS_BYTES = LDS_MISC_OFF + 1024;
constexpr int N_PHASES = 2 + 9 * 4;
constexpr int CV_I = 3072, CV_SC = 6144, CV_NX = 3072, CV_SO = 6144;
typedef const __attribute__((address_space(4))) P* KP;
__device__ __forceinline__ KP fresh(KP k) { asm volatile("" : "+s"(k)); return k; }
#if defined(__HIP_DEVICE_COMPILE__)
#define PL const P p = *fresh(kp)
#else
#define PL const P p = p_args
#endif
__global__ void __launch_bounds__(512, 2) k_fwd(P p_args, int ph_lo, int ph_hi) {
    const KP kp = (KP)__builtin_amdgcn_kernarg_segment_ptr(); (void)p_args;
    extern __shared__ __attribute__((aligned(16))) unsigned char lds_raw[];
    LAS unsigned char* lds = (LAS unsigned char*)lds_raw;
    const int tid = threadIdx.x; (void)ph_lo; (void)ph_hi;
    const int wv = __builtin_amdgcn_readfirstlane(tid >> 6);
    volatile LAS unsigned* MISC = (volatile LAS unsigned*)(lds + LDS_MISC_OFF);
    if (tid < 256) MISC[tid] = 0u;
    __syncthreads();
    { PL; const XcdBarrier b0 = xcd_barrier_post(p.bar, MISC + 8); if (tid == 0) MISC[10] = b0.x; }
#define GRID_SYNC() do { XcdBarrier b_; b_.bar = fresh(kp)->bar; b_.x = MISC[10]; b_.st = MISC + 8; xcd_barrier(b_); } while (0)
#if MK_PER_PHASE
#define IN(k) (ph_lo <= (k) && (k) < ph_hi)
#else
#define IN(k) true
#endif
#define SEAM(k) do { if (IN(k) && IN((k) + 1)) { GRID_SYNC(); if (PROBE_KIND == 11) GRID_SYNC(); } } while (0)
#define REPEAT(kind) for (int rep_ = 0; rep_ < ((PROBE_KIND == (kind)) ? 2 : 1); ++rep_)
#define REPBAR(kind) do { if (PROBE_KIND == (kind) && rep_ == 0) GRID_SYNC(); } while (0)

    if (IN(0)) REPEAT(10) {
        PL; mod_phase(p, lds, wv);
        const Ids I = fresh_ids(wv); const int gw = I.gw, ngw = I.ngw, lane = I.lane; LAS float* scr = (LAS float*)(lds + I.wid * 8704);
        cvt_seg(p.lru_w_in, p.wt_lru_in, 1024, 2560, 2, scr, gw, ngw, lane);
        cvt_seg(p.lru_w_out, p.wt_lru_out, 1280, 1024, 2, scr, gw, ngw, lane);
        cvt_seg(p.sg_w_out, p.wt_sg_out, 2048, 1024, 2, scr, gw, ngw, lane);
        cvt_seg(p.lru_w_a, p.wt_a, 128, 128, 40, scr, gw, ngw, lane);
        cvt_seg(p.lru_w_x, p.wt_x, 128, 128, 40, scr, gw, ngw, lane);
        __syncthreads();
        cvt_i8_panels(p.sg_w_in, p.wq_sg_in, p.wsc_sg_in, lds, I.bid, I.G, I.tid);
        REPBAR(10);
    }
    SEAM(0);
    if (IN(1)) REPEAT(7) { PL; rowA_phase(p, 0, wv, PROBE_KIND == 7 && rep_ == 0); REPBAR(7); }
    SEAM(1);
    for (int l = 0; l < 4; ++l) {
        const int jl = l >> 1, b = 2 + 9 * l;
        const size_t wmoe_off = (size_t)l * 3 * 16 * 1024 * 1024;
        if ((l & 1) == 0) {
            if (IN(b + 0)) REPEAT(1) { PL; const Ids I0 = fresh_ids(wv); pg8::Prob<pg8::K_LRU_IN, 1024> pr; pr.A = p.hn; pr.B0 = p.wt_lru_in + (size_t)jl * 2560 * 1024; pr.O0 = p.gate; pr.O1 = p.xpre; pr.S.init(NTOK, 2560, (int)gridDim.x, I0.bid); pr.tab = (LAS unsigned*)(lds + LDS_TAB_OFF); pg8::gemm_phase(lds, pr, wv); IDLE_CVT(1600, 0, CV_I); REPBAR(1); }
            SEAM(b + 0);
            if (IN(b + 1)) REPEAT(4) { PL; LruW W{p.wt_a, p.wt_x}; lru_scan_phase(p, W, jl, lds, wv); IDLE_CVT(NCK * 10, CV_I, CV_SC); REPBAR(4); }
            SEAM(b + 1);
            if (IN(b + 2)) REPEAT(5) { PL; lru_fix_phase(p, jl, wv); REPBAR(5); }
            SEAM(b + 2);
            if (IN(b + 3)) REPEAT(1) { PL; const Ids I0 = fresh_ids(wv); pg8::Prob<pg8::K_OUT, 1280> pr; pr.A = p.zl; pr.B0 = p.wt_lru_out + (size_t)jl * 1024 * 1280; pr.O0 = p.x; pr.gvec = p.mod + (size_t)l * 9 * 6144; pr.S.init(NTOK, 1024, (int)gridDim.x, I0.bid); pr.tab = (LAS unsigned*)(lds + LDS_TAB_OFF); pg8::gemm_phase(lds, pr, wv); IDLE_CVT(640, CV_SC, 8192); REPBAR(1); }
            SEAM(b + 3);
        } else {
            if (IN(b + 0)) REPEAT(1) { PL; const Ids I0 = fresh_ids(wv); pg8::Prob<pg8::K_SG_IN, 1024> pr; pr.A = p.hn8i; pr.B0 = p.wq_sg_in + (size_t)jl * 4096 * 1024; pr.O0 = p.proj; pr.vss = p.vss; pr.gsel = p.hsc; pr.gvec = p.wsc_sg_in + (size_t)jl * 4096; pr.S.init(NTOK, 4096, (int)gridDim.x, I0.bid); pr.tab = (LAS unsigned*)(lds + LDS_TAB_OFF); pg8::gemm_phase(lds, pr, wv); REPBAR(1); }
            SEAM(b + 0);
            if (IN(b + 1)) REPEAT(6) { PL; sgu_phase(p, jl, lds, wv); REPBAR(6); }
            SEAM(b + 1);
#if MK_PER_PHASE
            SEAM(b + 2);
#endif
            if (IN(b + 3)) REPEAT(1) { PL; const Ids I0 = fresh_ids(wv); pg8::Prob<pg8::K_OUT, 2048> pr; pr.A = p.zsg; pr.B0 = p.wt_sg_out + (size_t)jl * 1024 * 2048; pr.O0 = p.x; pr.gvec = p.mod + (size_t)l * 9 * 6144; pr.S.init(NTOK, 1024, (int)gridDim.x, I0.bid); pr.tab = (LAS unsigned*)(lds + LDS_TAB_OFF); pg8::gemm_phase(lds, pr, wv); IDLE_CVT(640, CV_NX, CV_SO); REPBAR(1); }
            SEAM(b + 3);
        }
        if (IN(b + 4)) for (int rep_ = 0; rep_ < ((PROBE_KIND == 8 || PROBE_KIND == 12) ? 2 : 1); ++rep_) { PL; rowB_phase(p, l, lds, wv, (PROBE_KIND == 8 || PROBE_KIND == 12) && rep_ == 0); if ((PROBE_KIND == 8 || PROBE_KIND == 12) && rep_ == 0) GRID_SYNC(); }
        SEAM(b + 4);
        if (IN(b + 5)) for (int rep_ = 0; rep_ < ((PROBE_KIND == 9 || (PROBE_KIND >= 16 && PROBE_KIND <= 17)) ? 2 : 1); ++rep_) {
            PL; const Ids I = fresh_ids(wv); const int bid = I.bid;
            if (bid < 32) { LAS unsigned (*red)[8] = (LAS unsigned (*)[8])lds; const int e = bid & 15;
                const bool xp = (PROBE_KIND >= 16 && PROBE_KIND <= 17 && rep_ == 0); const float* asrc = xp ? p.affT2 : p.affT;
                if (bid < 16) select_body<16>(p, asrc, e, 0, CAP_CTX, 0, red, wv, xp); else select_body<64>(p, asrc, e, NCTX, CAP_SMP, CAP_CTX, red, wv, xp); }
            else if (!(PROBE_KIND >= 16 && PROBE_KIND <= 17 && rep_ == 0)) { if (l & 1) cvt_moe_layer(p, l, (LAS float*)(lds + I.wid * 8704), (bid - 32) * 8 + I.wid, (I.G - 32) * 8, I.lane, CV_SO, 8192); else cvt_moe_layer(p, l + 1, (LAS float*)(lds + I.wid * 8704), (bid - 32) * 8 + I.wid, (I.G - 32) * 8, I.lane, 0, CV_NX); }
            if ((PROBE_KIND == 9 || (PROBE_KIND >= 16 && PROBE_KIND <= 17)) && rep_ == 0) GRID_SYNC();
        }
        SEAM(b + 5);
        if (IN(b + 6)) REPEAT(2) { PL; const Ids I0 = fresh_ids(wv); pg8::Prob<pg8::K_MOE1, 1024> pr; pr.A = p.hn8; pr.B0 = p.wt8 + wmoe_off; pr.B1 = p.wt8 + wmoe_off + (size_t)16 * 1024 * 1024; pr.O0 = p.hh8; pr.idx = p.idx; pr.S.init(NSLOT, 2048, (int)gridDim.x, I0.bid); pr.tab = (LAS unsigned*)(lds + LDS_TAB_OFF); pg8::gemm_phase(lds, pr, wv); REPBAR(2); }
        SEAM(b + 6);
        if (IN(b + 7)) REPEAT(2) { PL; const Ids I0 = fresh_ids(wv); pg8::Prob<pg8::K_MOE2, 1024> pr; pr.A = p.hh8; pr.B0 = p.wt8 + wmoe_off + (size_t)32 * 1024 * 1024; pr.O0 = p.outm; pr.gsel = p.gsel; pr.S.init(NSLOT, 1024, (int)gridDim.x, I0.bid); pr.tab = (LAS unsigned*)(lds + LDS_TAB_OFF); pg8::gemm_phase(lds, pr, wv); REPBAR(2); }
        SEAM(b + 7);
        if (IN(b + 8)) REPEAT(7) { PL; rowA_phase(p, l + 1, wv, PROBE_KIND == 7 && rep_ == 0); REPBAR(7); }
        SEAM(b + 8);
    }
#undef IN
#undef SEAM
}

static inline size_t al(size_t x) { return (x + 255) & ~(size_t)255; }
extern "C" void kernel_launch(void* const* d_in, const int* in_sizes, int n_in, void* d_out, int out_size, void* d_ws, size_t ws_size, hipStream_t stream) {
    P p{};
    const float* const* in = (const float* const*)d_in;
    p.x_prompt = in[0]; p.x_sample = in[1]; p.state_lru = in[2]; p.c = in[3]; p.c_ctx = in[4]; p.norm1_g = in[5]; p.norm2_g = in[6]; p.w_mod = in[7]; p.b_mod = in[8];
    p.lru_w_in = in[9]; p.lru_conv_w = in[10]; p.lru_conv_b = in[11]; p.lru_w_a = in[12]; p.lru_b_a = in[13]; p.lru_w_x = in[14]; p.lru_b_x = in[15]; p.lru_lam = in[16]; p.lru_w_out = in[17];
    p.sg_w_in = in[18]; p.sg_norm_g = in[19]; p.sg_w_s = in[20]; p.sg_b_s = in[21]; p.sg_w_out = in[22];
    p.moe_router = in[23]; p.moe_w_gate = in[24]; p.moe_w_up = in[25]; p.moe_w_down = in[26]; p.final_norm_g = in[27];
    p.xout = (float*)d_out; p.new_state = (float*)d_out + (size_t)NTOK * DM;
    char* w = (char*)d_ws; size_t o = 0;
    auto take = [&](size_t bytes) { char* r = w + o; o += al(bytes); return r; };
    p.bar = (unsigned*)take((size_t)XCD_BAR_WORDS * 4);
    p.mod = (float*)take((size_t)4 * 9 * 6144 * 4);
    p.x = (bf16_t*)take((size_t)NTOK * DM * 2);
    p.hn = (bf16_t*)take((size_t)NTOK * DM * 2);
    const size_t R = (size_t)NTOK * LW * 2;
    char* r1 = take(R); char* r2 = take(R); char* r3 = take(R); char* r4 = take(R); char* r5 = take(R);
    char* r6 = take((size_t)NTOK * SGW * 2 - R);
    (void)r6;
    p.gate = (bf16_t*)r1; p.xpre = (bf16_t*)r2; p.zl = (bf16_t*)r2; p.S = (bf16_t*)r3; p.Af = (unsigned char*)r4; p.Ab = (unsigned char*)r5;
    p.proj = (bf16_t*)r1; p.zsg = (bf16_t*)r5; p.hh8 = (unsigned char*)r1; p.hn8 = (unsigned char*)p.hn; p.hn8i = (signed char*)p.hn; p.outm = (unsigned char*)r3; p.y = (bf16_t*)r3;
    p.agg = (float*)take((size_t)NCK128 * 2 * 2 * LW * 4);
    p.k2tab = (float*)take((size_t)4 * LW * 4);
    p.vss = (float*)take((size_t)NTOK * 32 * 4);
    p.affT = (float*)take((size_t)NE * NTOK * 4);
    p.affT2 = (float*)take((size_t)NE * NTOK * 4);
    p.idx = (int*)take((size_t)NSLOT * 4);
    p.gsel = (float*)take((size_t)NSLOT * 4);
    p.inv = (int*)take((size_t)NE * NTOK * 4);
    p.wt_lru_in = (bf16_t*)take((size_t)2 * 2560 * 1024 * 2); p.wq_lru_in = nullptr; p.wsc_lru_in = nullptr;
    p.wt_lru_out = (bf16_t*)take((size_t)2 * 1024 * 1280 * 2);
    p.wq_sg_in = (signed char*)take((size_t)2 * 4096 * 1024); p.wsc_sg_in = (float*)take((size_t)2 * 4096 * 4); p.wpm_sg_in = (float*)take((size_t)16 * 2 * 4096 * 4);
    p.hsc = (float*)take((size_t)NTOK * 4);
    p.wt_sg_out = (bf16_t*)take((size_t)2 * 1024 * 2048 * 2);
    p.wt_a = (bf16_t*)take((size_t)40 * 128 * 128 * 2);
    p.wt_x = (bf16_t*)take((size_t)40 * 128 * 128 * 2);
    p.wt8 = (unsigned char*)take((size_t)4 * 3 * 16 * 1024 * 1024);
    (void)ws_size; (void)in_sizes; (void)n_in; (void)out_size;

    static int grid = 0;
    if (!grid) {
        int dev = 0, cus = 0;
        (void)hipGetDevice(&dev); (void)hipDeviceGetAttribute(&cus, hipDeviceAttributeMultiprocessorCount, dev);
        (void)hipFuncSetAttribute((const void*)k_fwd, hipFuncAttributeMaxDynamicSharedMemorySize, LDS_BYTES);
        grid = cus > 0 ? cus : 256;
    }
    (void)hipMemsetAsync(p.bar, 0, (size_t)XCD_BAR_WORDS * 4, stream);
#if MK_PER_PHASE
    for (int ph = 0; ph < N_PHASES; ++ph) hipLaunchKernelGGL(k_fwd, dim3(grid), dim3(512), LDS_BYTES, stream, p, ph, ph + 1);
#else
    hipLaunchKernelGGL(k_fwd, dim3(grid), dim3(512), LDS_BYTES, stream, p, 0, N_PHASES);
#endif
}
```
